# Optimizing an MI355X kernel written in HIP

```python
import jax, jax.numpy as jnp
from jax import lax
import numpy as np

D_MODEL = 2048
BATCH = 4
SEQ = 2048
DEPTH = 1

D_MIX = D_MODEL
D_POOL = D_MIX // 2
POOL_WINDOWS = (2, 4, 8, 16)
N_POOL_GROUPS = len(POOL_WINDOWS)
POOL_GROUP_DIM = D_POOL // N_POOL_GROUPS
D_GLA = D_MIX - D_POOL
GLA_HEADS = 4
GLA_DV = D_GLA // GLA_HEADS
GLA_DK_TOTAL = D_GLA // 2
GLA_DK = GLA_DK_TOTAL // GLA_HEADS
GLA_GATE_RANK = 16
GATE_LOGIT_NORMALIZER = 16.0
CHUNK = 64
D_IN = D_POOL + 2 * GLA_DK_TOTAL + 2 * D_GLA + GLA_GATE_RANK
D_FF = 5632
EPS = 1e-6

kernel_name = "hymba_pool_gla_macaron_block"


def rmsnorm(x, g):
    xf = x.astype(jnp.float32)
    y = xf * lax.rsqrt(jnp.mean(xf * xf, axis=-1, keepdims=True) + EPS)
    return (y * g.astype(jnp.float32)).astype(x.dtype)


def swiglu(h, w_in, w_out):
    gu = h @ w_in
    gate, up = gu[..., :D_FF], gu[..., D_FF:]
    return (jax.nn.silu(gate) * up) @ w_out


def pool_mixer(u, w_pool, pool_scale):
    B, S, _ = u.shape
    uf = u.astype(jnp.float32).reshape(B, S, N_POOL_GROUPS, POOL_GROUP_DIM)
    cs = jnp.cumsum(uf, axis=1)
    pos1 = jnp.arange(1, S + 1, dtype=jnp.int32)
    means = []
    for gi, w in enumerate(POOL_WINDOWS):
        c = cs[:, :, gi]
        shifted = jnp.pad(c, ((0, 0), (w, 0), (0, 0)))[:, :S]
        cnt = jnp.minimum(pos1, w).astype(jnp.float32)[None, :, None]
        means.append((c - shifted) / cnt)
    pooled = jnp.stack(means, axis=2) - uf
    y = jnp.einsum('bsgc,gcd->bsgd', pooled.astype(u.dtype), w_pool)
    return y.reshape(B, S, D_POOL) * pool_scale


def gla_mixer(q, k, v, g_out, gate_lr, w_alpha, b_alpha, gla_norm):
    B, S, _ = q.shape
    N = S // CHUNK
    log_alpha = jax.nn.log_sigmoid((gate_lr @ w_alpha + b_alpha).astype(jnp.float32)) / GATE_LOGIT_NORMALIZER

    def heads(t, d):
        return t.astype(jnp.float32).reshape(B, N, CHUNK, GLA_HEADS, d).transpose(0, 3, 1, 2, 4)

    qh = heads(q, GLA_DK) * (GLA_DK ** -0.5)
    kh = heads(k, GLA_DK)
    vh = heads(v, GLA_DV)
    bcum = jnp.cumsum(heads(log_alpha, GLA_DK), axis=3)
    b_last = bcum[:, :, :, -1:]
    q_dec = qh * jnp.exp(bcum)
    k_inv = kh * jnp.exp(-bcum)
    k_tail = kh * jnp.exp(b_last - bcum)

    mask = jnp.tril(jnp.ones((CHUNK, CHUNK), dtype=bool))
    scores = jnp.where(mask, jnp.einsum('bhnid,bhnjd->bhnij', q_dec, k_inv), 0.0)
    o_intra = jnp.einsum('bhnij,bhnjv->bhniv', scores, vh)

    kv_chunk = jnp.einsum('bhncd,bhncv->bhndv', k_tail, vh)
    decay_chunk = jnp.exp(b_last[:, :, :, 0])

    def step(state, inp):
        dec, kv = inp
        return state * dec[..., None] + kv, state

    init = jnp.zeros((B, GLA_HEADS, GLA_DK, GLA_DV), jnp.float32)
    _, states = lax.scan(step, init, (decay_chunk.transpose(2, 0, 1, 3), kv_chunk.transpose(2, 0, 1, 3, 4)))
    states = states.transpose(1, 2, 0, 3, 4)
    o = o_intra + jnp.einsum('bhncd,bhndv->bhncv', q_dec, states)

    o = o * lax.rsqrt(jnp.mean(o * o, axis=-1, keepdims=True) + EPS) * gla_norm.astype(jnp.float32)
    o = o.transpose(0, 2, 3, 1, 4).reshape(B, S, D_GLA)
    return (o * jax.nn.silu(g_out.astype(jnp.float32))).astype(q.dtype)


def setup_inputs(seed: int = 0) -> dict:
    key = jax.random.key(seed)
    ks = jax.random.split(key, 16)
    f32 = jnp.float32

    def nrm(k, shape, fan_in):
        return jax.random.normal(k, shape, f32) * (fan_in ** -0.5)

    def gain(k, shape):
        return 1.0 + 0.02 * jax.random.normal(k, shape, f32)

    L = DEPTH
    return {
        "x": jax.random.normal(ks[0], (BATCH, SEQ, D_MODEL), f32),
        "ffn1_norm": gain(ks[1], (L, D_MODEL)),
        "ffn1_w_in": nrm(ks[2], (L, D_MODEL, 2 * D_FF), D_MODEL),
        "ffn1_w_out": nrm(ks[3], (L, D_FF, D_MODEL), D_FF),
        "mix_norm": gain(ks[4], (L, D_MODEL)),
        "w_in_mix": nrm(ks[5], (L, D_MODEL, D_IN), D_MODEL),
        "w_pool": nrm(ks[6], (L, N_POOL_GROUPS, POOL_GROUP_DIM, POOL_GROUP_DIM), POOL_GROUP_DIM),
        "pool_scale": 1.0 + 0.1 * jax.random.normal(ks[7], (L, D_POOL), f32),
        "w_alpha": nrm(ks[8], (L, GLA_GATE_RANK, GLA_DK_TOTAL), GLA_GATE_RANK),
        "b_alpha": 0.01 * jax.random.normal(ks[9], (L, GLA_DK_TOTAL), f32),
        "gla_norm": gain(ks[10], (L, GLA_DV)),
        "w_out_mix": nrm(ks[11], (L, D_MIX, D_MODEL), D_MIX),
        "ffn2_norm": gain(ks[12], (L, D_MODEL)),
        "ffn2_w_in": nrm(ks[13], (L, D_MODEL, 2 * D_FF), D_MODEL),
        "ffn2_w_out": nrm(ks[14], (L, D_FF, D_MODEL), D_FF),
        "final_norm": gain(ks[15], (D_MODEL,)),
    }


def reference(x, ffn1_norm, ffn1_w_in, ffn1_w_out, mix_norm, w_in_mix, w_pool, pool_scale,
              w_alpha, b_alpha, gla_norm, w_out_mix, ffn2_norm, ffn2_w_in, ffn2_w_out, final_norm):
    h = x
    o_q = D_POOL
    o_k = o_q + GLA_DK_TOTAL
    o_v = o_k + GLA_DK_TOTAL
    o_g = o_v + D_GLA
    o_r = o_g + D_GLA
    for l in range(DEPTH):
        h = h + 0.5 * swiglu(rmsnorm(h, ffn1_norm[l]), ffn1_w_in[l], ffn1_w_out[l])
        u = rmsnorm(h, mix_norm[l]) @ w_in_mix[l]
        y_pool = pool_mixer(u[..., :o_q], w_pool[l], pool_scale[l])
        y_gla = gla_mixer(u[..., o_q:o_k], u[..., o_k:o_v], u[..., o_v:o_g], u[..., o_g:o_r],
                          u[..., o_r:], w_alpha[l], b_alpha[l], gla_norm[l])
        h = h + jnp.concatenate([y_pool.astype(h.dtype), y_gla.astype(h.dtype)], axis=-1) @ w_out_mix[l]
        h = h + 0.5 * swiglu(rmsnorm(h, ffn2_norm[l]), ffn2_w_in[l], ffn2_w_out[l])
    return rmsnorm(h, final_norm)
```

```cpp
#include <hip/hip_runtime.h>
#include <hip/hip_cooperative_groups.h>
#include <cstdio>
#include <cstdint>
namespace cg = cooperative_groups;
namespace pg8 {
#define PG8_LAS __attribute__((address_space(3)))
typedef unsigned short bf16_t;
typedef short bf16x8 __attribute__((ext_vector_type(8)));
typedef float f32x4 __attribute__((ext_vector_type(4)));
typedef unsigned u32x4 __attribute__((ext_vector_type(4)));
constexpr int BM = 256, BK = 64, HALF = 128, HTB = HALF * BK * 2  , STAGE_BYTES = 8 * HTB, NXCD = 8, WGM = 8;

__host__ __device__ __forceinline__ int lds_byte(int r, int c) { const int st = (r >> 4) * 2 + (c >> 5), rr = r & 15, cc = c & 31, ob = rr * 64 + cc * 2; return st * 1024 + (ob ^ (((ob >> 9) & 1) << 5)); }
__host__ __device__ __forceinline__ void stage_rc(int b, int& R, int& C) { const int st = b / 1024, sb = b % 1024, swz = sb ^ (((sb >> 9) & 1) << 5); R = (st >> 1) * 16 + swz / 64; C = (st & 1) * 32 + (swz % 64) / 2; }
__host__ __device__ __forceinline__ int perm32(int rho) { const int n = rho >> 4, i = rho & 15; return 8 * (i >> 2) + 4 * n + (i & 3); }

struct Unit { int pm, pn; };
struct Gemm { const bf16_t* A; const bf16_t* Bt; int M, N, K; };

struct StaticOrder {
    int nM, nN, nwg, G, c;
    __host__ __device__ void init(int M, int N, int G_, int c_) { nM = M / BM; nN = N / BM; nwg = nM * nN; G = G_; c = c_; }
    __host__ __device__ bool next(int i, Unit& u) const {
        const long L = (long)i * G + c; if (L >= nwg) return false;
        int wgid = (int)L; { const int q = nwg / NXCD, r = nwg % NXCD, xcd = wgid % NXCD, off = wgid / NXCD; wgid = (xcd < r ? xcd * (q + 1) : r * (q + 1) + (xcd - r) * q) + off; }
        const int nig = WGM * nN, gid = wgid / nig, fm = gid * WGM, gsz = (nM - fm) < WGM ? (nM - fm) : WGM;
        u.pm = fm + ((wgid % nig) % gsz); u.pn = (wgid % nig) / gsz; return true;
    }
    __device__ __forceinline__ void a_ready(const Unit&) const {}
    __device__ __forceinline__ void done(const Unit&) const {}
};

__device__ __forceinline__ unsigned cvt_pk_bf16(float lo, float hi) { unsigned r; asm volatile("v_cvt_pk_bf16_f32 %0, %1, %2" : "=v"(r) : "v"(lo), "v"(hi)); return r; }
typedef float f32x2 __attribute__((ext_vector_type(2)));
constexpr float RMS_EPS = 1e-6f;
typedef unsigned u32x2 __attribute__((ext_vector_type(2)));
__device__ __forceinline__ float silu_f(float g) { return g * __builtin_amdgcn_rcpf(1.0f + __builtin_amdgcn_exp2f(-1.44269504089f * g)); }

struct EpiSwiGLU {
    static constexpr bool PERM = true, AFTER_DRAIN = false;
    bf16_t* O; int ldc; const float* rowss; float inv_d;
    __device__ __forceinline__ void operator()(const f32x4 (&acc)[2][2][4][2], const Unit& u, int wr, int wc, int fr, int fq) const {
        const int row0 = u.pm * BM + wr * 64 + fr, col0 = u.pn * HALF + wc * 32 + 8 * fq;
#pragma unroll
        for (int ai = 0; ai < 2; ++ai)
#pragma unroll
            for (int m = 0; m < 4; ++m) {
                const int row = row0 + ai * HALF + m * 16;
                const float rs = rsqrtf(rowss[row] * inv_d + RMS_EPS);
                const f32x4 g0 = acc[ai][0][m][0] * rs, g1 = acc[ai][0][m][1] * rs, u0 = acc[ai][1][m][0] * rs, u1 = acc[ai][1][m][1] * rs;
                u32x4 w;
                w.x = cvt_pk_bf16(silu_f(g0[0]) * u0[0], silu_f(g0[1]) * u0[1]); w.y = cvt_pk_bf16(silu_f(g0[2]) * u0[2], silu_f(g0[3]) * u0[3]);
                w.z = cvt_pk_bf16(silu_f(g1[0]) * u1[0], silu_f(g1[1]) * u1[1]); w.w = cvt_pk_bf16(silu_f(g1[2]) * u1[2], silu_f(g1[3]) * u1[3]);
                *(u32x4*)(O + (size_t)row * ldc + col0) = w;
            }
    }
};
struct EpiScaleBf16 {
    static constexpr bool PERM = true, AFTER_DRAIN = false;
    bf16_t* O; int ldc; const float* rowss; float inv_d;
    __device__ __forceinline__ void operator()(const f32x4 (&acc)[2][2][4][2], const Unit& u, int wr, int wc, int fr, int fq) const {
        const int row0 = u.pm * BM + wr * 64 + fr, col0 = u.pn * BM + wc * 32 + 8 * fq;
#pragma unroll
        for (int ai = 0; ai < 2; ++ai)
#pragma unroll
            for (int m = 0; m < 4; ++m) {
                const int row = row0 + ai * HALF + m * 16;
                const float rs = rsqrtf(rowss[row] * inv_d + RMS_EPS);
                bf16_t* rowp = O + (size_t)row * ldc + col0;
#pragma unroll
                for (int bj = 0; bj < 2; ++bj) { const f32x4 v0 = acc[ai][bj][m][0] * rs, v1 = acc[ai][bj][m][1] * rs;
                    u32x4 w; w.x = cvt_pk_bf16(v0[0], v0[1]); w.y = cvt_pk_bf16(v0[2], v0[3]); w.z = cvt_pk_bf16(v1[0], v1[1]); w.w = cvt_pk_bf16(v1[2], v1[3]);
                    *(u32x4*)(rowp + bj * HALF) = w; }
            }
    }
};
struct EpiResid {
    static constexpr bool PERM = false, AFTER_DRAIN = false;
    const float* base; float* out; float alpha; bf16_t* HG; const float* gvec; float* rowss_out;
    __device__ __forceinline__ void operator()(const f32x4 (&acc)[2][2][4][2], const Unit& u, int wr, int wc, int fr, int fq) const {
        const int row0 = u.pm * BM + wr * 64 + fr, col0 = u.pn * BM + wc * 32 + 4 * fq;
        f32x4 gv[2][2];
#pragma unroll
        for (int bj = 0; bj < 2; ++bj)
#pragma unroll
            for (int n = 0; n < 2; ++n) gv[bj][n] = HG ? *(const f32x4*)(gvec + col0 + bj * HALF + n * 16) : (f32x4){0.f, 0.f, 0.f, 0.f};
#pragma unroll
        for (int ai = 0; ai < 2; ++ai)
#pragma unroll
            for (int m = 0; m < 4; ++m) {
                const int row = row0 + ai * HALF + m * 16; const size_t off = (size_t)row * 2048 + col0; float ss = 0.f;
#pragma unroll
                for (int bj = 0; bj < 2; ++bj)
#pragma unroll
                    for (int n = 0; n < 2; ++n) {
                        const f32x4 b = *(const f32x4*)(base + off + bj * HALF + n * 16);
                        const f32x4 h = b + acc[ai][bj][m][n] * alpha;
                        *(f32x4*)(out + off + bj * HALF + n * 16) = h;
                        ss += (h[0] * h[0] + h[1] * h[1]) + (h[2] * h[2] + h[3] * h[3]);
                        if (HG) { const f32x4 t = h * gv[bj][n]; u32x2 w; w.x = cvt_pk_bf16(t[0], t[1]); w.y = cvt_pk_bf16(t[2], t[3]); *(u32x2*)(HG + off + bj * HALF + n * 16) = w; }
                    }
                ss += __shfl_xor(ss, 16); ss += __shfl_xor(ss, 32);
                if (fq == 0) atomicAdd(rowss_out + row, ss);
                if (m & 1) asm volatile("" ::: "memory");
            }
    }
};
template <class Epi, class Sched, bool ALIGN_EPI = false, bool SP2 = false>
__device__ __forceinline__ void gemm_phase(PG8_LAS unsigned char* lds, const Gemm g, const Sched& S, const Epi& E) {
    const int tid = threadIdx.x, wid = __builtin_amdgcn_readfirstlane(tid >> 6), lane = tid & 63, wr = wid >> 2, wc = wid & 3, fr = lane & 15, fq = lane >> 4;
    const int K = g.K, nt = K / BK;
    unsigned voffA[2], voffB[2];
#pragma unroll
    for (int i = 0; i < 2; ++i) { int R, C; stage_rc(tid * 16 + i * 8192, R, C); const int Rb = Epi::PERM ? ((R & ~31) + perm32(R & 31)) : R;
        voffA[i] = (unsigned)(R * K + C) * 2u; voffB[i] = (unsigned)(Rb * K + C) * 2u; }
    const size_t kstep = (size_t)(BK * 2);
    const size_t hstep = (size_t)HALF * K * 2;
    const size_t tstep = 2 * hstep;
    const unsigned ldsw = (unsigned)wid * 1024u;
    const int aoff = lds_byte(wr * 64 + fr, fq * 8), boff = lds_byte(wc * 32 + fr, fq * 8);
#define PG8_SA(b, h) (((b) * 2 + (h)) * HTB)
#define PG8_SB(b, h) ((4 + (b) * 2 + (h)) * HTB)
#define PG8_STAGE(bufoff, gbase, voff) do { _Pragma("unroll") for (int _i = 0; _i < 2; ++_i) \
        __builtin_amdgcn_global_load_lds((const unsigned*)((const char*)(gbase) + (voff)[_i]), (PG8_LAS unsigned*)(lds + (bufoff) + ldsw + _i * 8192), 16, 0, 0); } while (0)
#define PG8_LDA(dst, b, h) do { _Pragma("unroll") for (int m = 0; m < 4; ++m) _Pragma("unroll") for (int k = 0; k < 2; ++k) dst[m][k] = *(const PG8_LAS bf16x8*)(lds + PG8_SA(b, h) + aoff + m * 2048 + k * 1024); } while (0)
#define PG8_LDB(dst, b, h) do { _Pragma("unroll") for (int n = 0; n < 2; ++n) _Pragma("unroll") for (int k = 0; k < 2; ++k) dst[n][k] = *(const PG8_LAS bf16x8*)(lds + PG8_SB(b, h) + boff + n * 2048 + k * 1024); } while (0)
#define PG8_MMA(ai, bj, At, Bt) do { __builtin_amdgcn_s_setprio(1); _Pragma("unroll") for (int m = 0; m < 4; ++m) _Pragma("unroll") for (int n = 0; n < 2; ++n) _Pragma("unroll") for (int k = 0; k < 2; ++k) \
        acc[ai][bj][m][n] = __builtin_amdgcn_mfma_f32_16x16x32_bf16(Bt[n][k], At[m][k], acc[ai][bj][m][n], 0, 0, 0); __builtin_amdgcn_s_setprio(0); } while (0)
#define PG8_WAIT_V(n) asm volatile("s_waitcnt vmcnt(" #n ")" ::: "memory")
#define PG8_WAIT_L(n) asm volatile("s_waitcnt lgkmcnt(" #n ")" ::: "memory")
#define PG8_BAR __builtin_amdgcn_s_barrier()
#define PG8_SCHED __builtin_amdgcn_sched_barrier(0)
    Unit cur, nxt; int ui = 0;
    if (!S.next(0, cur)) return;
    f32x4 acc[2][2][4][2];
#pragma unroll
    for (int a = 0; a < 2; ++a)
#pragma unroll
        for (int b = 0; b < 2; ++b)
#pragma unroll
            for (int m = 0; m < 4; ++m)
#pragma unroll
                for (int n = 0; n < 2; ++n) acc[a][b][m][n] = (f32x4){0.f, 0.f, 0.f, 0.f};
    bf16x8 At[4][2], B0[2][2], B1[2][2];
    const char* cA = (const char*)g.A + (size_t)cur.pm * tstep; const char* cB = (const char*)g.Bt + (size_t)cur.pn * tstep;
    S.a_ready(cur);
    if constexpr (SP2) {
        PG8_STAGE(PG8_SB(0, 0), cB, voffB); PG8_STAGE(PG8_SB(0, 1), cB + hstep, voffB); PG8_STAGE(PG8_SA(0, 0), cA, voffA); PG8_STAGE(PG8_SA(0, 1), cA + hstep, voffA);
        if (wr == 1) PG8_BAR;
        PG8_WAIT_V(2); PG8_BAR;
        PG8_STAGE(PG8_SB(1, 0), cB + kstep, voffB); PG8_STAGE(PG8_SA(1, 0), cA + kstep, voffA); PG8_STAGE(PG8_SB(1, 1), cB + hstep + kstep, voffB);
        PG8_WAIT_V(6); PG8_BAR;
    } else {
        PG8_STAGE(PG8_SB(0, 0), cB, voffB); PG8_STAGE(PG8_SA(0, 0), cA, voffA); PG8_STAGE(PG8_SB(0, 1), cB + hstep, voffB); PG8_STAGE(PG8_SA(0, 1), cA + hstep, voffA);
        if (wr == 1) PG8_BAR;
        PG8_WAIT_V(4); PG8_BAR;
        PG8_STAGE(PG8_SB(1, 0), cB + kstep, voffB); PG8_STAGE(PG8_SA(1, 0), cA + kstep, voffA); PG8_STAGE(PG8_SB(1, 1), cB + hstep + kstep, voffB);
        PG8_WAIT_V(6); PG8_BAR;
    }
    for (;;) {
        const bool has_next = S.next(ui + 1, nxt);
        const char* nA = has_next ? (const char*)g.A + (size_t)nxt.pm * tstep : cA; const char* nB = has_next ? (const char*)g.Bt + (size_t)nxt.pn * tstep : cB;
        for (int t = 0; t < nt; t += 2) {
            const bool last = (t == nt - 2);
            const char* a1 = cA + (size_t)(t + 1) * kstep;
            const char* a2 = last ? nA : cA + (size_t)(t + 2) * kstep; const char* b2 = last ? nB : cB + (size_t)(t + 2) * kstep;
            const char* a3 = a2 + kstep; const char* b3 = b2 + kstep;
            if (last && has_next) S.a_ready(nxt);
            if constexpr (SP2) {
            PG8_LDB(B0, 0, 0); PG8_LDB(B1, 0, 1); PG8_SCHED; PG8_LDA(At, 0, 0); PG8_STAGE(PG8_SA(1, 1), a1 + hstep, voffA);
            PG8_WAIT_V(8); PG8_WAIT_L(0); PG8_BAR; PG8_MMA(0, 0, At, B0); PG8_MMA(0, 1, At, B1); PG8_BAR; PG8_SCHED;
            PG8_LDA(At, 0, 1); PG8_STAGE(PG8_SB(0, 0), b2, voffB); PG8_STAGE(PG8_SB(0, 1), b2 + hstep, voffB); PG8_STAGE(PG8_SA(0, 0), a2, voffA);
            PG8_WAIT_V(8); PG8_WAIT_L(0); PG8_BAR; PG8_MMA(1, 0, At, B0); PG8_MMA(1, 1, At, B1); PG8_BAR; PG8_SCHED;
            PG8_LDB(B0, 1, 0); PG8_LDB(B1, 1, 1); PG8_SCHED; PG8_LDA(At, 1, 0); PG8_STAGE(PG8_SA(0, 1), a2 + hstep, voffA);
            PG8_WAIT_V(8); PG8_WAIT_L(0); PG8_BAR; PG8_MMA(0, 0, At, B0); PG8_MMA(0, 1, At, B1); PG8_BAR; PG8_SCHED;
            PG8_LDA(At, 1, 1); PG8_STAGE(PG8_SB(1, 0), b3, voffB); PG8_STAGE(PG8_SB(1, 1), b3 + hstep, voffB); PG8_STAGE(PG8_SA(1, 0), a3, voffA);
            PG8_WAIT_V(8); PG8_WAIT_L(0); PG8_BAR; PG8_MMA(1, 0, At, B0); PG8_MMA(1, 1, At, B1); PG8_BAR; PG8_SCHED;
            } else {
            PG8_LDB(B0, 0, 0); PG8_SCHED; PG8_LDA(At, 0, 0); PG8_STAGE(PG8_SA(1, 1), a1 + hstep, voffA);
            PG8_WAIT_L(8); PG8_BAR; PG8_WAIT_L(0); PG8_MMA(0, 0, At, B0); PG8_BAR; PG8_SCHED;
            PG8_LDB(B1, 0, 1); PG8_STAGE(PG8_SB(0, 0), b2, voffB);
            PG8_BAR; PG8_WAIT_L(0); PG8_MMA(0, 1, At, B1); PG8_BAR;
            PG8_LDA(At, 0, 1); PG8_STAGE(PG8_SA(0, 0), a2, voffA);
            PG8_BAR; PG8_WAIT_L(0); PG8_MMA(1, 0, At, B0); PG8_BAR; PG8_SCHED;
            PG8_STAGE(PG8_SB(0, 1), b2 + hstep, voffB);
            PG8_WAIT_V(6); PG8_BAR; PG8_MMA(1, 1, At, B1); PG8_BAR;
            PG8_LDB(B0, 1, 0); PG8_SCHED; PG8_LDA(At, 1, 0); PG8_STAGE(PG8_SA(0, 1), a2 + hstep, voffA);
            PG8_WAIT_L(8); PG8_BAR; PG8_WAIT_L(0); PG8_MMA(0, 0, At, B0); PG8_BAR; PG8_SCHED;
            PG8_LDB(B1, 1, 1); PG8_STAGE(PG8_SB(1, 0), b3, voffB);
            PG8_BAR; PG8_WAIT_L(0); PG8_MMA(0, 1, At, B1); PG8_BAR;
            PG8_LDA(At, 1, 1); PG8_STAGE(PG8_SA(1, 0), a3, voffA);
            PG8_BAR; PG8_WAIT_L(0); PG8_MMA(1, 0, At, B0); PG8_BAR; PG8_SCHED;
            PG8_STAGE(PG8_SB(1, 1), b3 + hstep, voffB);
            PG8_WAIT_V(6); PG8_BAR; PG8_MMA(1, 1, At, B1); PG8_BAR;
            }
        }
        if constexpr (ALIGN_EPI) { if (wr == 0) PG8_BAR; }
        if constexpr (!Epi::AFTER_DRAIN) { E(acc, cur, wr, wc, fr, fq); S.done(cur); }
        if (!has_next) break;
#pragma unroll
        for (int a = 0; a < 2; ++a)
#pragma unroll
            for (int b = 0; b < 2; ++b)
#pragma unroll
                for (int m = 0; m < 4; ++m)
#pragma unroll
                    for (int n = 0; n < 2; ++n) acc[a][b][m][n] = (f32x4){0.f, 0.f, 0.f, 0.f};
        cur = nxt; cA = nA; cB = nB; ++ui;
        if constexpr (ALIGN_EPI) { if (wr == 1) PG8_BAR; }
    }
    PG8_WAIT_V(0);
    if constexpr (!ALIGN_EPI) { if (wr == 0) PG8_BAR; }
    PG8_BAR;
    if constexpr (Epi::AFTER_DRAIN) { E.fused(acc, cur, wr, wc, fr, fq, lds, wid, lane); S.done(cur); }
#undef PG8_SA
#undef PG8_SB
#undef PG8_STAGE
#undef PG8_LDA
#undef PG8_LDB
#undef PG8_MMA
#undef PG8_WAIT_V
#undef PG8_WAIT_L
#undef PG8_BAR
#undef PG8_SCHED
}
}
using pg8::bf16_t; using pg8::bf16x8; using pg8::f32x4; using pg8::u32x4; using pg8::u32x2; using pg8::cvt_pk_bf16; using pg8::silu_f; using pg8::RMS_EPS;
#define LAS __attribute__((address_space(3)))
#define LDS_WAIT() asm volatile("s_waitcnt lgkmcnt(0)" ::: "memory")

constexpr int DM = 2048, SEQ = 2048, M = 8192, DFF = 5632, DIN = 4112, DU = 4096;
constexpr int OQ = 1024, OKK = 1536, OV = 2048, OG = 3072;
constexpr int NWAVES = 8, NTHR = 512;
constexpr float INV_DM = 1.0f / 2048.0f;

constexpr size_t MiB = 1u << 20;
constexpr size_t WS_ROWSS = 0;
constexpr size_t WS_GL = 256 * 1024;
constexpr size_t WS_DEC = 1 * MiB;
constexpr size_t WS_W1IN = 2 * MiB, WS_W1OUT = 46 * MiB, WS_WMIX = 68 * MiB, WS_WPOOL = 85 * MiB, WS_WOUT = 86 * MiB, WS_W2IN = 94 * MiB, WS_W2OUT = 138 * MiB;
constexpr size_t WS_A = 160 * MiB, WS_ACT = 192 * MiB, WS_U = 192 * MiB, WS_Y = 256 * MiB, WS_KVT = 2 * MiB, WS_END = 288 * MiB;

constexpr int RING_BYTES = 131072, LDS_BYTES = 147456;

__device__ __forceinline__ unsigned f2bf(float f) { unsigned u = __builtin_bit_cast(unsigned, f); return (u + 0x7fffu + ((u >> 16) & 1u)) >> 16; }
__device__ __forceinline__ unsigned pk2(float lo, float hi) { return f2bf(lo) | (f2bf(hi) << 16); }
__device__ __forceinline__ float bf_lo(unsigned v) { return __builtin_bit_cast(float, v << 16); }
__device__ __forceinline__ float bf_hi(unsigned v) { return __builtin_bit_cast(float, v & 0xffff0000u); }
__device__ __forceinline__ float wave_sum(float v) {
#pragma unroll
    for (int o = 1; o < 64; o <<= 1) v += __shfl_xor(v, o);
    return v;
}
#define MFMA16(a, b, c) __builtin_amdgcn_mfma_f32_16x16x32_bf16((a), (b), (c), 0, 0, 0)

__device__ __forceinline__ int swiglu_row(int n) { return n < DFF ? ((n >> 7) * 256 + (n & 127)) : (((n - DFF) >> 7) * 256 + 128 + ((n - DFF) & 127)); }
__device__ __forceinline__ void transpose_item(const float* W, int K, int N, bf16_t* WT, int mode, LAS float* scr, int item, int lane) {
    const int nblk = (N + 31) / 32, kb = item / nblk, nb = item % nblk, k0 = 64 * kb, n0 = 32 * nb;
    const int ncol = n0 + (lane & 31); const bool ok = ncol < N;
#pragma unroll 8
    for (int i = 0; i < 32; ++i) { const int kk = 2 * i + (lane >> 5); scr[kk * 33 + (lane & 31)] = ok ? W[(size_t)(k0 + kk) * N + ncol] : 0.f; }
    LDS_WAIT();
    const int c = lane & 7;
#pragma unroll
    for (int j = 0; j < 4; ++j) { const int n = (lane >> 3) + 8 * j; const LAS float* s = scr + (8 * c) * 33 + n;
        u32x4 o; o.x = pk2(s[0 * 33], s[1 * 33]); o.y = pk2(s[2 * 33], s[3 * 33]); o.z = pk2(s[4 * 33], s[5 * 33]); o.w = pk2(s[6 * 33], s[7 * 33]);
        const int nn = n0 + n;
        if (nn < N) { const int drow = mode == 1 ? swiglu_row(nn) : nn; *(u32x4*)(WT + (size_t)drow * K + k0 + 8 * c) = o; } }
    LDS_WAIT();
}

struct Args { const float* in[16]; float* out; unsigned char* ws; int ph_lo, ph_hi; };

__device__ __forceinline__ void p0_prologue(const Args& a, LAS unsigned char* lds, int gw, int NGW, int lane, int wave) {
    unsigned char* ws = a.ws;
    LAS float* scr = (LAS float*)(lds + wave * 16384);
    constexpr int I_IN = (DM / 64) * (2 * DFF / 32), I_OUT = (DFF / 64) * (DM / 32), I_MIX = (DM / 64) * ((DIN + 31) / 32), I_POOL1 = (256 / 64) * (256 / 32), I_O = (DM / 64) * (DM / 32);
    constexpr int NITEMS = 2 * I_IN + 2 * I_OUT + I_MIX + 4 * I_POOL1 + I_O;
    for (int it = gw; it < NITEMS; it += NGW) {
        int r = it;
        if (r < I_IN) { transpose_item(a.in[2], DM, 2 * DFF, (bf16_t*)(ws + WS_W1IN), 1, scr, r, lane); continue; } r -= I_IN;
        if (r < I_OUT) { transpose_item(a.in[3], DFF, DM, (bf16_t*)(ws + WS_W1OUT), 0, scr, r, lane); continue; } r -= I_OUT;
        if (r < I_MIX) { transpose_item(a.in[5], DM, DIN, (bf16_t*)(ws + WS_WMIX), 0, scr, r, lane); continue; } r -= I_MIX;
        if (r < 4 * I_POOL1) { const int g = r / I_POOL1; transpose_item(a.in[6] + g * 65536, 256, 256, (bf16_t*)(ws + WS_WPOOL) + g * 65536, 0, scr, r % I_POOL1, lane); continue; } r -= 4 * I_POOL1;
        if (r < I_O) { transpose_item(a.in[11], DM, DM, (bf16_t*)(ws + WS_WOUT), 0, scr, r, lane); continue; } r -= I_O;
        if (r < I_IN) { transpose_item(a.in[13], DM, 2 * DFF, (bf16_t*)(ws + WS_W2IN), 1, scr, r, lane); continue; } r -= I_IN;
        transpose_item(a.in[14], DFF, DM, (bf16_t*)(ws + WS_W2OUT), 0, scr, r, lane);
    }
    const float* x = a.in[0]; const float* g1 = a.in[1]; bf16_t* A = (bf16_t*)(ws + WS_A); float* rowss = (float*)(ws + WS_ROWSS);
    for (int m = gw; m < M; m += NGW) {
        const f32x4* xr = (const f32x4*)(x + (size_t)m * DM) + lane; const f32x4* gr = (const f32x4*)g1 + lane;
        u32x2* o = (u32x2*)(A + (size_t)m * DM) + lane; float s = 0.f;
#pragma unroll
        for (int j = 0; j < 8; ++j) { const f32x4 v = xr[64 * j]; const f32x4 g = gr[64 * j]; s += (v[0] * v[0] + v[1] * v[1]) + (v[2] * v[2] + v[3] * v[3]);
            u32x2 w; w.x = cvt_pk_bf16(v[0] * g[0], v[1] * g[1]); w.y = cvt_pk_bf16(v[2] * g[2], v[3] * g[3]); o[64 * j] = w; }
        s = wave_sum(s);
        if (lane == 0) { rowss[m] = s; rowss[M + m] = 0.f; rowss[2 * M + m] = 0.f; rowss[3 * M + m] = 0.f; }
    }
}

__device__ __forceinline__ void gatelr_phase(const bf16_t* A, const bf16_t* WTr, const float* rowss, float* GL, LAS unsigned char* lds, int G, int tid, int wave, int lane) {
    const int fr = lane & 15, fq = lane >> 4, tg = wave >> 2, kq = wave & 3;
    LAS float* P = (LAS float*)lds;
    for (int tb = blockIdx.x; tb < M / 32; tb += G) {
        const int t0 = 32 * tb;
        const bf16_t* ap = A + (size_t)(t0 + 16 * tg + fr) * DM + kq * 512 + 8 * fq;
        const bf16_t* bp = WTr + (size_t)fr * DM + kq * 512 + 8 * fq;
        f32x4 acc = {0.f, 0.f, 0.f, 0.f};
#pragma unroll 8
        for (int ks = 0; ks < 16; ++ks) { const bf16x8 av = *(const bf16x8*)(ap + 32 * ks); const bf16x8 bv = *(const bf16x8*)(bp + 32 * ks); acc = MFMA16(av, bv, acc); }
        *(LAS f32x4*)(P + (wave * 64 + lane) * 4) = acc;
        __syncthreads();
        { const int tok = tid >> 4, r = tid & 15, tg2 = tok >> 4, tl = tok & 15, ln = r + 16 * (tl >> 2), j = tl & 3; float s = 0.f;
#pragma unroll
          for (int q = 0; q < 4; ++q) s += P[((tg2 * 4 + q) * 64 + ln) * 4 + j];
          GL[(size_t)(t0 + tok) * 16 + r] = s * rsqrtf(rowss[t0 + tok] * INV_DM + RMS_EPS); }
        __syncthreads();
    }
}

__device__ __forceinline__ void pool_task(int task, const bf16_t* U, const bf16_t* WpT, const float* pool_scale, bf16_t* Y, LAS unsigned char* lds, int tid, int wave, int lane) {
    const int tt = task >> 2, g = task & 3, T0 = 64 * tt, p0 = T0 % SEQ, w = 2 << g;
    const int fr = lane & 15, fq = lane >> 4;
    LAS bf16_t* UL = (LAS bf16_t*)lds;
    LAS bf16_t* PA = (LAS bf16_t*)(lds + 40960);
#pragma unroll
    for (int i = 0; i < 5; ++i) { const int ch = tid + 512 * i, r = ch >> 5, c16 = ch & 31, pos = p0 - 16 + r;
        u32x4 v = {0u, 0u, 0u, 0u};
        if (pos >= 0) v = *(const u32x4*)(U + (size_t)(T0 - 16 + r) * DU + g * 256 + c16 * 8);
        *(LAS u32x4*)(UL + r * 256 + c16 * 8) = v; }
    __syncthreads();
    {
        const int cp = tid & 127, tq = tid >> 7, i0 = 16 * tq;
        const LAS unsigned* UL32 = (const LAS unsigned*)UL; LAS unsigned* PA32 = (LAS unsigned*)PA;
        float s0 = 0.f, s1 = 0.f;
        for (int s = i0 - w + 1; s < i0; ++s) { const unsigned v = UL32[(s + 16) * 128 + cp]; s0 += bf_lo(v); s1 += bf_hi(v); }
        for (int i = i0; i < i0 + 16; ++i) {
            const unsigned v = UL32[(i + 16) * 128 + cp]; const float a0 = bf_lo(v), a1 = bf_hi(v);
            s0 += a0; s1 += a1;
            const int pos = p0 + i; const int cnt = (pos + 1) < w ? (pos + 1) : w; const float inv = 1.0f / (float)cnt;
            PA32[i * 132 + cp] = cvt_pk_bf16(s0 * inv - a0, s1 * inv - a1);
            const unsigned o = UL32[(i - w + 1 + 16) * 128 + cp]; s0 -= bf_lo(o); s1 -= bf_hi(o);
        }
    }
    __syncthreads();
    f32x4 acc[4][2];
#pragma unroll
    for (int mt = 0; mt < 4; ++mt)
#pragma unroll
        for (int nt = 0; nt < 2; ++nt) acc[mt][nt] = (f32x4){0.f, 0.f, 0.f, 0.f};
    const bf16_t* wp = WpT + (size_t)g * 65536 + (size_t)(32 * wave + fr) * 256 + 8 * fq;
#pragma unroll
    for (int ks = 0; ks < 8; ++ks) {
        bf16x8 wf[2];
#pragma unroll
        for (int nt = 0; nt < 2; ++nt) wf[nt] = *(const bf16x8*)(wp + nt * 16 * 256 + 32 * ks);
#pragma unroll
        for (int mt = 0; mt < 4; ++mt) { const bf16x8 af = *(const LAS bf16x8*)(PA + (16 * mt + fr) * 264 + 32 * ks + 8 * fq);
#pragma unroll
            for (int nt = 0; nt < 2; ++nt) acc[mt][nt] = MFMA16(wf[nt], af, acc[mt][nt]); }
    }
#pragma unroll
    for (int nt = 0; nt < 2; ++nt) { const int n = 32 * wave + 16 * nt + 4 * fq; const f32x4 sc = *(const f32x4*)(pool_scale + g * 256 + n);
#pragma unroll
        for (int mt = 0; mt < 4; ++mt) { const f32x4 v = acc[mt][nt] * sc; u32x2 o; o.x = cvt_pk_bf16(v[0], v[1]); o.y = cvt_pk_bf16(v[2], v[3]);
            *(u32x2*)(Y + (size_t)(T0 + 16 * mt + fr) * DM + g * 256 + n) = o; } }
    __syncthreads();
}

__device__ __forceinline__ void gla_bcum(const float* GL, const float* w_alpha, const float* b_alpha, int T0, int h, LAS float* GLs, LAS float* BC, LAS float* SEG, int tid) {
    for (int i = tid; i < 1024; i += NTHR) GLs[i] = GL[(size_t)T0 * 16 + i];
    const int d = tid & 127, q = tid >> 7;
    float wa[16];
#pragma unroll
    for (int r = 0; r < 16; ++r) wa[r] = w_alpha[r * 512 + h * 128 + d];
    const float ba = b_alpha[h * 128 + d];
    __syncthreads();
    float c = 0.f;
#pragma unroll 4
    for (int tt = 0; tt < 16; ++tt) { const int t = 16 * q + tt; float z = ba;
#pragma unroll
        for (int r = 0; r < 16; ++r) z += GLs[t * 16 + r] * wa[r];
        const float ls = fminf(z, 0.f) - log1pf(expf(-fabsf(z)));
        c += ls * 0.0625f; BC[t * 128 + d] = c; }
    SEG[q * 128 + d] = c;
    __syncthreads();
    float off = 0.f;
    for (int qq = 0; qq < q; ++qq) off += SEG[qq * 128 + d];
    if (q > 0) {
#pragma unroll 4
        for (int tt = 0; tt < 16; ++tt) BC[(16 * q + tt) * 128 + d] += off; }
    __syncthreads();
}
__device__ __forceinline__ u32x4 pack8(const unsigned (&b)[8]) { u32x4 o; o.x = b[0] | (b[1] << 16); o.y = b[2] | (b[3] << 16); o.z = b[4] | (b[5] << 16); o.w = b[6] | (b[7] << 16); return o; }
__device__ __forceinline__ void gla_stage_vt(const bf16_t* U, int T0, int h, LAS bf16_t* VT, int tid) {
    const int dvp = tid & 127, cgrp = tid >> 7;
#pragma unroll
    for (int hf = 0; hf < 2; ++hf) { const int c8 = 16 * cgrp + 8 * hf; unsigned a[8], b[8];
#pragma unroll
        for (int cc = 0; cc < 8; ++cc) { const unsigned vv = *(const unsigned*)(U + (size_t)(T0 + c8 + cc) * DU + OV + h * 256 + 2 * dvp); a[cc] = vv & 0xffffu; b[cc] = vv >> 16; }
        *(LAS u32x4*)(VT + (2 * dvp) * 72 + c8) = pack8(a); *(LAS u32x4*)(VT + (2 * dvp + 1) * 72 + c8) = pack8(b); }
}
constexpr int GL_OFF = 0, BC_OFF = 4096, SEG_OFF = 36864;
__device__ __forceinline__ void gla_kv_task(int task, const bf16_t* U, const float* GL, const float* w_alpha, const float* b_alpha, float* KVT, float* DEC, LAS unsigned char* lds, int tid, int wave, int lane) {
    const int b = task >> 7, h = (task >> 5) & 3, n = task & 31, T0 = b * SEQ + n * 64;
    const int fr = lane & 15, fq = lane >> 4;
    LAS float* GLs = (LAS float*)(lds + GL_OFF); LAS float* BC = (LAS float*)(lds + BC_OFF); LAS float* SEG = (LAS float*)(lds + SEG_OFF);
    LAS bf16_t* KT = (LAS bf16_t*)(lds + 38912);
    LAS bf16_t* VT = (LAS bf16_t*)(lds + 57344);
    gla_bcum(GL, w_alpha, b_alpha, T0, h, GLs, BC, SEG, tid);
    { const int dp = tid & 63, cg8 = tid >> 6; const float bl0 = BC[63 * 128 + 2 * dp], bl1 = BC[63 * 128 + 2 * dp + 1]; unsigned k0[8], k1[8];
#pragma unroll
      for (int cc = 0; cc < 8; ++cc) { const int c = 8 * cg8 + cc; const unsigned kv = *(const unsigned*)(U + (size_t)(T0 + c) * DU + OKK + h * 128 + 2 * dp);
          k0[cc] = f2bf(bf_lo(kv) * expf(bl0 - BC[c * 128 + 2 * dp])); k1[cc] = f2bf(bf_hi(kv) * expf(bl1 - BC[c * 128 + 2 * dp + 1])); }
      *(LAS u32x4*)(KT + (2 * dp) * 72 + 8 * cg8) = pack8(k0); *(LAS u32x4*)(KT + (2 * dp + 1) * 72 + 8 * cg8) = pack8(k1); }
    gla_stage_vt(U, T0, h, VT, tid);
    __syncthreads();
    f32x4 acc[2][8];
#pragma unroll
    for (int mt = 0; mt < 2; ++mt)
#pragma unroll
        for (int nt = 0; nt < 8; ++nt) acc[mt][nt] = (f32x4){0.f, 0.f, 0.f, 0.f};
#pragma unroll
    for (int ks = 0; ks < 2; ++ks) { bf16x8 vf[2];
#pragma unroll
        for (int mt = 0; mt < 2; ++mt) vf[mt] = *(const LAS bf16x8*)(VT + (32 * wave + 16 * mt + fr) * 72 + 32 * ks + 8 * fq);
#pragma unroll
        for (int nt = 0; nt < 8; ++nt) { const bf16x8 kf = *(const LAS bf16x8*)(KT + (16 * nt + fr) * 72 + 32 * ks + 8 * fq);
#pragma unroll
            for (int mt = 0; mt < 2; ++mt) acc[mt][nt] = MFMA16(kf, vf[mt], acc[mt][nt]); } }
    float* kvp = KVT + (size_t)task * 32768;
#pragma unroll
    for (int mt = 0; mt < 2; ++mt)
#pragma unroll
        for (int nt = 0; nt < 8; ++nt) *(f32x4*)(kvp + (32 * wave + 16 * mt + fr) * 128 + 16 * nt + 4 * fq) = acc[mt][nt];
    if (tid < 128) DEC[task * 128 + tid] = expf(BC[63 * 128 + tid]);
    __syncthreads();
}
__device__ __forceinline__ void gla_scan_phase(float* KVT, const float* DEC, int G, int tid) {
    for (int e = blockIdx.x * NTHR + tid; e < 16 * 8192; e += G * NTHR) {
        const int bh = e >> 13, e4 = e & 8191, dk0 = (e4 * 4) & 127;
        f32x4 st = {0.f, 0.f, 0.f, 0.f};
        for (int n0 = 0; n0 < 32; n0 += 8) { f32x4 kv[8], dc[8];
#pragma unroll
            for (int j = 0; j < 8; ++j) { kv[j] = *(const f32x4*)(KVT + (size_t)(bh * 32 + n0 + j) * 32768 + e4 * 4); dc[j] = *(const f32x4*)(DEC + (bh * 32 + n0 + j) * 128 + dk0); }
#pragma unroll
            for (int j = 0; j < 8; ++j) { *(f32x4*)(KVT + (size_t)(bh * 32 + n0 + j) * 32768 + e4 * 4) = st; st = st * dc[j] + kv[j]; } }
    }
}
__device__ __forceinline__ void gla_out_task(int task, const bf16_t* U, const float* GL, const float* w_alpha, const float* b_alpha, const float* KVT, const float* gla_norm, bf16_t* Y, LAS unsigned char* lds, int tid, int wave, int lane) {
    const int b = task >> 7, h = (task >> 5) & 3, n = task & 31, T0 = b * SEQ + n * 64;
    const int fr = lane & 15, fq = lane >> 4;
    LAS float* GLs = (LAS float*)(lds + GL_OFF); LAS float* BC = (LAS float*)(lds + BC_OFF); LAS float* SEG = (LAS float*)(lds + SEG_OFF);
    LAS bf16_t* QD = (LAS bf16_t*)(lds + 38912);
    LAS bf16_t* KI = (LAS bf16_t*)(lds + 56320);
    LAS bf16_t* SC = (LAS bf16_t*)(lds + 73728);
    LAS bf16_t* VT = (LAS bf16_t*)(lds + 82944);
    LAS float* RS = (LAS float*)(lds + 119808);
    gla_bcum(GL, w_alpha, b_alpha, T0, h, GLs, BC, SEG, tid);
    { const int dp = tid & 63, cg8 = tid >> 6; LAS unsigned* QD32 = (LAS unsigned*)QD; LAS unsigned* KI32 = (LAS unsigned*)KI; const float qs = 0.08838834764831845f;
#pragma unroll
      for (int cc = 0; cc < 8; ++cc) { const int c = 8 * cg8 + cc; const bf16_t* up = U + (size_t)(T0 + c) * DU + h * 128 + 2 * dp;
          const unsigned q2 = *(const unsigned*)(up + OQ), k2 = *(const unsigned*)(up + OKK); const float b0 = BC[c * 128 + 2 * dp], b1 = BC[c * 128 + 2 * dp + 1];
          QD32[c * 68 + dp] = cvt_pk_bf16(bf_lo(q2) * qs * expf(b0), bf_hi(q2) * qs * expf(b1));
          KI32[c * 68 + dp] = cvt_pk_bf16(bf_lo(k2) * expf(-b0), bf_hi(k2) * expf(-b1)); } }
    gla_stage_vt(U, T0, h, VT, tid);
    __syncthreads();
    { const int it = wave & 3, jp = wave >> 2;
#pragma unroll
      for (int jj = 0; jj < 2; ++jj) { const int jt = 2 * jp + jj; f32x4 s = {0.f, 0.f, 0.f, 0.f};
          if (jt <= it) {
#pragma unroll
              for (int ks = 0; ks < 4; ++ks) { const bf16x8 kf = *(const LAS bf16x8*)(KI + (16 * jt + fr) * 136 + 32 * ks + 8 * fq); const bf16x8 qf = *(const LAS bf16x8*)(QD + (16 * it + fr) * 136 + 32 * ks + 8 * fq);
                  s = MFMA16(kf, qf, s); } }
          const int i = 16 * it + fr, j0 = 16 * jt + 4 * fq;
          u32x2 o; o.x = cvt_pk_bf16(j0 + 0 <= i ? s[0] : 0.f, j0 + 1 <= i ? s[1] : 0.f); o.y = cvt_pk_bf16(j0 + 2 <= i ? s[2] : 0.f, j0 + 3 <= i ? s[3] : 0.f);
          *(LAS u32x2*)(SC + i * 72 + j0) = o; } }
    __syncthreads();
    f32x4 acc[4][2];
#pragma unroll
    for (int mt = 0; mt < 4; ++mt)
#pragma unroll
        for (int nt = 0; nt < 2; ++nt) acc[mt][nt] = (f32x4){0.f, 0.f, 0.f, 0.f};
#pragma unroll
    for (int ks = 0; ks < 2; ++ks) { bf16x8 vf[2];
#pragma unroll
        for (int nt = 0; nt < 2; ++nt) vf[nt] = *(const LAS bf16x8*)(VT + (32 * wave + 16 * nt + fr) * 72 + 32 * ks + 8 * fq);
#pragma unroll
        for (int mt = 0; mt < 4; ++mt) { const bf16x8 sf = *(const LAS bf16x8*)(SC + (16 * mt + fr) * 72 + 32 * ks + 8 * fq);
#pragma unroll
            for (int nt = 0; nt < 2; ++nt) acc[mt][nt] = MFMA16(vf[nt], sf, acc[mt][nt]); } }
    const float* stp = KVT + (size_t)task * 32768;
#pragma unroll
    for (int ks = 0; ks < 4; ++ks) { bf16x8 sf[2];
#pragma unroll
        for (int nt = 0; nt < 2; ++nt) { const float* p = stp + (32 * wave + 16 * nt + fr) * 128 + 32 * ks + 8 * fq; const f32x4 lo = *(const f32x4*)p, hi = *(const f32x4*)(p + 4);
            u32x4 w; w.x = cvt_pk_bf16(lo[0], lo[1]); w.y = cvt_pk_bf16(lo[2], lo[3]); w.z = cvt_pk_bf16(hi[0], hi[1]); w.w = cvt_pk_bf16(hi[2], hi[3]); sf[nt] = __builtin_bit_cast(bf16x8, w); }
#pragma unroll
        for (int mt = 0; mt < 4; ++mt) { const bf16x8 qf = *(const LAS bf16x8*)(QD + (16 * mt + fr) * 136 + 32 * ks + 8 * fq);
#pragma unroll
            for (int nt = 0; nt < 2; ++nt) acc[mt][nt] = MFMA16(sf[nt], qf, acc[mt][nt]); } }
#pragma unroll
    for (int mt = 0; mt < 4; ++mt) { float s = 0.f;
#pragma unroll
        for (int nt = 0; nt < 2; ++nt) { const f32x4 v = acc[mt][nt]; s += (v[0] * v[0] + v[1] * v[1]) + (v[2] * v[2] + v[3] * v[3]); }
        s += __shfl_xor(s, 16); s += __shfl_xor(s, 32);
        if (fq == 0) RS[wave * 64 + 16 * mt + fr] = s; }
    __syncthreads();
#pragma unroll
    for (int mt = 0; mt < 4; ++mt) { float tot = 0.f;
#pragma unroll
        for (int w8 = 0; w8 < 8; ++w8) tot += RS[w8 * 64 + 16 * mt + fr];
        const float rstd = rsqrtf(tot * (1.0f / 256.0f) + RMS_EPS); const int tok = T0 + 16 * mt + fr;
#pragma unroll
        for (int nt = 0; nt < 2; ++nt) { const int dv = 32 * wave + 16 * nt + 4 * fq; const f32x4 gn = *(const f32x4*)(gla_norm + dv);
            const u32x2 g2 = *(const u32x2*)(U + (size_t)tok * DU + OG + h * 256 + dv); const f32x4 v = acc[mt][nt] * rstd * gn;
            u32x2 o; o.x = cvt_pk_bf16(v[0] * silu_f(bf_lo(g2.x)), v[1] * silu_f(bf_hi(g2.x))); o.y = cvt_pk_bf16(v[2] * silu_f(bf_lo(g2.y)), v[3] * silu_f(bf_hi(g2.y)));
            *(u32x2*)(Y + (size_t)tok * DM + 1024 + h * 256 + dv) = o; } }
    __syncthreads();
}

__global__ void __launch_bounds__(NTHR, 2) mk_fwd(Args args) {
    extern __shared__ __attribute__((aligned(16))) unsigned char lds_raw[];
    LAS unsigned char* lds = (LAS unsigned char*)lds_raw;
    cg::grid_group grid = cg::this_grid();
    const int tid = threadIdx.x, lane = tid & 63, wave = __builtin_amdgcn_readfirstlane(tid >> 6);
    const int G = gridDim.x, bx = blockIdx.x;
    const int vcu = (G % 8 == 0) ? (bx % 8) * (G / 8) + bx / 8 : bx;
    const int gw = vcu * NWAVES + wave, NGW = G * NWAVES;
    unsigned char* ws = args.ws;
    float* rowss = (float*)(ws + WS_ROWSS); float* GL = (float*)(ws + WS_GL); float* DEC = (float*)(ws + WS_DEC);
    bf16_t* A = (bf16_t*)(ws + WS_A); bf16_t* ACT = (bf16_t*)(ws + WS_ACT); bf16_t* U = (bf16_t*)(ws + WS_U); bf16_t* Y = (bf16_t*)(ws + WS_Y); float* KVT = (float*)(ws + WS_KVT);
    const int lo = args.ph_lo, hi = args.ph_hi;
#define IN(k) (lo <= (k) && (k) < hi)
#define SEAM(k) do { if (IN(k) && IN((k) + 1)) grid.sync(); } while (0)

    if (IN(0)) { p0_prologue(args, lds, gw, NGW, lane, wave); }
    SEAM(0);
    if (IN(1)) { pg8::Gemm g{A, (const bf16_t*)(ws + WS_W1IN), M, 2 * DFF, DM}; pg8::StaticOrder S; S.init(M, 2 * DFF, G, bx);
        pg8::EpiSwiGLU E{ACT, DFF, rowss, INV_DM};
        pg8::gemm_phase<pg8::EpiSwiGLU, pg8::StaticOrder, true, true>(lds, g, S, E); }
    SEAM(1);
    if (IN(2)) { pg8::Gemm g{ACT, (const bf16_t*)(ws + WS_W1OUT), M, DM, DFF}; pg8::StaticOrder S; S.init(M, DM, G, bx);
        pg8::EpiResid E{args.in[0], args.out, 0.5f, A, args.in[4], rowss + M};
        pg8::gemm_phase<pg8::EpiResid, pg8::StaticOrder, true, true>(lds, g, S, E); }
    SEAM(2);
    if (IN(3)) { gatelr_phase(A, (const bf16_t*)(ws + WS_WMIX) + (size_t)DU * DM, rowss + M, GL, lds, G, tid, wave, lane);
        pg8::Gemm g{A, (const bf16_t*)(ws + WS_WMIX), M, DU, DM}; pg8::StaticOrder S; S.init(M, DU, G, bx);
        pg8::EpiScaleBf16 E{U, DU, rowss + M, INV_DM};
        pg8::gemm_phase<pg8::EpiScaleBf16, pg8::StaticOrder, true, true>(lds, g, S, E); }
    SEAM(3);
    if (IN(4)) { for (int t = bx; t < 1024; t += G) {
            if (t < 512) gla_kv_task(t, U, GL, args.in[8], args.in[9], KVT, DEC, lds, tid, wave, lane);
            else pool_task(t - 512, U, (const bf16_t*)(ws + WS_WPOOL), args.in[7], Y, lds, tid, wave, lane); } }
    SEAM(4);
    if (IN(5)) { gla_scan_phase(KVT, DEC, G, tid); }
    SEAM(5);
    if (IN(6)) { for (int t = bx; t < 512; t += G) gla_out_task(t, U, GL, args.in[8], args.in[9], KVT, args.in[10], Y, lds, tid, wave, lane); }
    SEAM(6);
    if (IN(7)) { pg8::Gemm g{Y, (const bf16_t*)(ws + WS_WOUT), M, DM, DM}; pg8::StaticOrder S; S.init(M, DM, G, bx);
        pg8::EpiResid E{args.out, args.out, 1.0f, A, args.in[12], rowss + 2 * M};
        pg8::gemm_phase<pg8::EpiResid, pg8::StaticOrder, true, true>(lds, g, S, E); }
    SEAM(7);
    if (IN(8)) { pg8::Gemm g{A, (const bf16_t*)(ws + WS_W2IN), M, 2 * DFF, DM}; pg8::StaticOrder S; S.init(M, 2 * DFF, G, bx);
        pg8::EpiSwiGLU E{ACT, DFF, rowss + 2 * M, INV_DM};
        pg8::gemm_phase<pg8::EpiSwiGLU, pg8::StaticOrder, true, true>(lds, g, S, E); }
    SEAM(8);
    if (IN(9)) { pg8::Gemm g{ACT, (const bf16_t*)(ws + WS_W2OUT), M, DM, DFF}; pg8::StaticOrder S; S.init(M, DM, G, bx);
        pg8::EpiResid E{args.out, args.out, 0.5f, nullptr, nullptr, rowss + 3 * M};
        pg8::gemm_phase<pg8::EpiResid, pg8::StaticOrder, true, true>(lds, g, S, E); }
    SEAM(9);
    if (IN(10)) { const float* fn = args.in[15];
        for (int m = gw; m < M; m += NGW) { f32x4* orow = (f32x4*)(args.out + (size_t)m * DM) + lane; const f32x4* gr = (const f32x4*)fn + lane;
            const float rs = rsqrtf(rowss[3 * M + m] * INV_DM + RMS_EPS);
#pragma unroll
            for (int j = 0; j < 8; ++j) { const f32x4 v = orow[64 * j]; orow[64 * j] = v * rs * gr[64 * j]; } } }
#undef IN
#undef SEAM
}

#ifndef MK_N_LAUNCHES
#define MK_N_LAUNCHES 1
#endif
extern "C" void kernel_launch(void* const* d_in, const int* in_sizes, int n_in, void* d_out, int out_size, void* d_ws, size_t ws_size, hipStream_t stream) {
    static int grid = 0;
    if (grid == 0) {
        if (n_in != 16 || out_size != M * DM || ws_size < WS_END) { fprintf(stderr, "kernel_launch: unexpected shapes (n_in %d out %d ws %zu)\n", n_in, out_size, ws_size); grid = -1; return; }
        int dev = 0, cus = 0, per_cu = 0;
        if (hipGetDevice(&dev) != hipSuccess || hipDeviceGetAttribute(&cus, hipDeviceAttributeMultiprocessorCount, dev) != hipSuccess) { grid = -1; return; }
        if (hipFuncSetAttribute((const void*)mk_fwd, hipFuncAttributeMaxDynamicSharedMemorySize, LDS_BYTES) != hipSuccess) { fprintf(stderr, "kernel_launch: hipFuncSetAttribute failed\n"); grid = -1; return; }
        if (hipOccupancyMaxActiveBlocksPerMultiprocessor(&per_cu, (const void*)mk_fwd, NTHR, LDS_BYTES) != hipSuccess || per_cu < 1) { fprintf(stderr, "kernel_launch: occupancy query says %d\n", per_cu); per_cu = 1; }
        (void)hipGetLastError();
        grid = cus;
    }
    if (grid < 0) return;
    Args a{};
    for (int i = 0; i < 16; ++i) a.in[i] = (const float*)d_in[i];
    a.out = (float*)d_out; a.ws = (unsigned char*)d_ws;
#if MK_N_LAUNCHES == 1
    a.ph_lo = 0; a.ph_hi = 11;
    void* kargs[] = {&a};
    hipError_t e = hipLaunchCooperativeKernel((const void*)mk_fwd, dim3(grid), dim3(NTHR), kargs, LDS_BYTES, stream);
    if (e != hipSuccess) fprintf(stderr, "kernel_launch: cooperative launch failed: %s (grid %d)\n", hipGetErrorString(e), grid);
#else
    for (int p = 0; p < 11; ++p) { a.ph_lo = p; a.ph_hi = p + 1; hipLaunchKernelGGL(mk_fwd, dim3(grid), dim3(NTHR), LDS_BYTES, stream, a); }
#endif
}
```

```cpp
#include <hip/hip_runtime.h>
#include <hip/hip_cooperative_groups.h>
#include <cstdio>
#include <cstdint>
namespace cg = cooperative_groups;
namespace pg8 {
#define PG8_LAS __attribute__((address_space(3)))
typedef unsigned short bf16_t;
typedef short bf16x8 __attribute__((ext_vector_type(8)));
typedef float f32x4 __attribute__((ext_vector_type(4)));
typedef unsigned u32x4 __attribute__((ext_vector_type(4)));
constexpr int BM = 256, BK = 64, HALF = 128, HTB = HALF * BK * 2  , STAGE_BYTES = 8 * HTB, NXCD = 8, WGM = 8;

__host__ __device__ __forceinline__ int lds_byte(int r, int c) { const int st = (r >> 4) * 2 + (c >> 5), rr = r & 15, cc = c & 31, ob = rr * 64 + cc * 2; return st * 1024 + (ob ^ (((ob >> 9) & 1) << 5)); }
__host__ __device__ __forceinline__ void stage_rc(int b, int& R, int& C) { const int st = b / 1024, sb = b % 1024, swz = sb ^ (((sb >> 9) & 1) << 5); R = (st >> 1) * 16 + swz / 64; C = (st & 1) * 32 + (swz % 64) / 2; }
__host__ __device__ __forceinline__ int perm32(int rho) { const int n = rho >> 4, i = rho & 15; return 8 * (i >> 2) + 4 * n + (i & 3); }

struct Unit { int pm, pn; };
struct Gemm { const bf16_t* A; const bf16_t* Bt; int M, N, K; };

struct StaticOrder {
    int nM, nN, nwg, G, c;
    __host__ __device__ void init(int M, int N, int G_, int c_) { nM = M / BM; nN = N / BM; nwg = nM * nN; G = G_; c = c_; }
    __host__ __device__ bool next(int i, Unit& u) const {
        const long L = (long)i * G + c; if (L >= nwg) return false;
        int wgid = (int)L; { const int q = nwg / NXCD, r = nwg % NXCD, xcd = wgid % NXCD, off = wgid / NXCD; wgid = (xcd < r ? xcd * (q + 1) : r * (q + 1) + (xcd - r) * q) + off; }
        const int nig = WGM * nN, gid = wgid / nig, fm = gid * WGM, gsz = (nM - fm) < WGM ? (nM - fm) : WGM;
        u.pm = fm + ((wgid % nig) % gsz); u.pn = (wgid % nig) / gsz; return true;
    }
    __device__ __forceinline__ void a_ready(const Unit&) const {}
    __device__ __forceinline__ void done(const Unit&) const {}
};

__device__ __forceinline__ unsigned cvt_pk_bf16(float lo, float hi) { unsigned r; asm volatile("v_cvt_pk_bf16_f32 %0, %1, %2" : "=v"(r) : "v"(lo), "v"(hi)); return r; }
typedef float f32x2 __attribute__((ext_vector_type(2)));
constexpr float RMS_EPS = 1e-6f;
typedef unsigned u32x2 __attribute__((ext_vector_type(2)));
__device__ __forceinline__ float silu_f(float g) { return g * __builtin_amdgcn_rcpf(1.0f + __builtin_amdgcn_exp2f(-1.44269504089f * g)); }

struct EpiSwiGLU {
    static constexpr bool PERM = true, AFTER_DRAIN = false;
    bf16_t* O; int ldc; const float* rowss; float inv_d;
    __device__ __forceinline__ void operator()(const f32x4 (&acc)[2][2][4][2], const Unit& u, int wr, int wc, int fr, int fq) const {
        const int row0 = u.pm * BM + wr * 64 + fr, col0 = u.pn * HALF + wc * 32 + 8 * fq;
#pragma unroll
        for (int ai = 0; ai < 2; ++ai)
#pragma unroll
            for (int m = 0; m < 4; ++m) {
                const int row = row0 + ai * HALF + m * 16;
                const float rs = rsqrtf(rowss[row] * inv_d + RMS_EPS);
                const f32x4 g0 = acc[ai][0][m][0] * rs, g1 = acc[ai][0][m][1] * rs, u0 = acc[ai][1][m][0] * rs, u1 = acc[ai][1][m][1] * rs;
                u32x4 w;
                w.x = cvt_pk_bf16(silu_f(g0[0]) * u0[0], silu_f(g0[1]) * u0[1]); w.y = cvt_pk_bf16(silu_f(g0[2]) * u0[2], silu_f(g0[3]) * u0[3]);
                w.z = cvt_pk_bf16(silu_f(g1[0]) * u1[0], silu_f(g1[1]) * u1[1]); w.w = cvt_pk_bf16(silu_f(g1[2]) * u1[2], silu_f(g1[3]) * u1[3]);
                *(u32x4*)(O + (size_t)row * ldc + col0) = w;
            }
    }
};
struct EpiScaleBf16 {
    static constexpr bool PERM = true, AFTER_DRAIN = false;
    bf16_t* O; int ldc; const float* rowss; float inv_d;
    __device__ __forceinline__ void operator()(const f32x4 (&acc)[2][2][4][2], const Unit& u, int wr, int wc, int fr, int fq) const {
        const int row0 = u.pm * BM + wr * 64 + fr, col0 = u.pn * BM + wc * 32 + 8 * fq;
#pragma unroll
        for (int ai = 0; ai < 2; ++ai)
#pragma unroll
            for (int m = 0; m < 4; ++m) {
                const int row = row0 + ai * HALF + m * 16;
                const float rs = rsqrtf(rowss[row] * inv_d + RMS_EPS);
                bf16_t* rowp = O + (size_t)row * ldc + col0;
#pragma unroll
                for (int bj = 0; bj < 2; ++bj) { const f32x4 v0 = acc[ai][bj][m][0] * rs, v1 = acc[ai][bj][m][1] * rs;
                    u32x4 w; w.x = cvt_pk_bf16(v0[0], v0[1]); w.y = cvt_pk_bf16(v0[2], v0[3]); w.z = cvt_pk_bf16(v1[0], v1[1]); w.w = cvt_pk_bf16(v1[2], v1[3]);
                    *(u32x4*)(rowp + bj * HALF) = w; }
            }
    }
};
struct EpiResid {
    static constexpr bool PERM = false, AFTER_DRAIN = false;
    const float* base; float* out; float alpha; bf16_t* HG; const float* gvec; float* rowss_out;
    __device__ __forceinline__ void operator()(const f32x4 (&acc)[2][2][4][2], const Unit& u, int wr, int wc, int fr, int fq) const {
        const int row0 = u.pm * BM + wr * 64 + fr, col0 = u.pn * BM + wc * 32 + 4 * fq;
        f32x4 gv[2][2];
#pragma unroll
        for (int bj = 0; bj < 2; ++bj)
#pragma unroll
            for (int n = 0; n < 2; ++n) gv[bj][n] = HG ? *(const f32x4*)(gvec + col0 + bj * HALF + n * 16) : (f32x4){0.f, 0.f, 0.f, 0.f};
#pragma unroll
        for (int ai = 0; ai < 2; ++ai)
#pragma unroll
            for (int m = 0; m < 4; ++m) {
                const int row = row0 + ai * HALF + m * 16; const size_t off = (size_t)row * 2048 + col0; float ss = 0.f;
#pragma unroll
                for (int bj = 0; bj < 2; ++bj)
#pragma unroll
                    for (int n = 0; n < 2; ++n) {
                        const f32x4 b = *(const f32x4*)(base + off + bj * HALF + n * 16);
                        const f32x4 h = b + acc[ai][bj][m][n] * alpha;
                        *(f32x4*)(out + off + bj * HALF + n * 16) = h;
                        ss += (h[0] * h[0] + h[1] * h[1]) + (h[2] * h[2] + h[3] * h[3]);
                        if (HG) { const f32x4 t = h * gv[bj][n]; u32x2 w; w.x = cvt_pk_bf16(t[0], t[1]); w.y = cvt_pk_bf16(t[2], t[3]); *(u32x2*)(HG + off + bj * HALF + n * 16) = w; }
                    }
                ss += __shfl_xor(ss, 16); ss += __shfl_xor(ss, 32);
                if (fq == 0) atomicAdd(rowss_out + row, ss);
                if (m & 1) asm volatile("" ::: "memory");
            }
    }
};
template <class Epi, class Sched, bool ALIGN_EPI = false, bool SP2 = false>
__device__ __forceinline__ void gemm_phase(PG8_LAS unsigned char* lds, const Gemm g, const Sched& S, const Epi& E) {
    const int tid = threadIdx.x, wid = __builtin_amdgcn_readfirstlane(tid >> 6), lane = tid & 63, wr = wid >> 2, wc = wid & 3, fr = lane & 15, fq = lane >> 4;
    const int K = g.K, nt = K / BK;
    unsigned voffA[2], voffB[2];
#pragma unroll
    for (int i = 0; i < 2; ++i) { int R, C; stage_rc(tid * 16 + i * 8192, R, C); const int Rb = Epi::PERM ? ((R & ~31) + perm32(R & 31)) : R;
        voffA[i] = (unsigned)(R * K + C) * 2u; voffB[i] = (unsigned)(Rb * K + C) * 2u; }
    const size_t kstep = (size_t)(BK * 2);
    const size_t hstep = (size_t)HALF * K * 2;
    const size_t tstep = 2 * hstep;
    const unsigned ldsw = (unsigned)wid * 1024u;
    const int aoff = lds_byte(wr * 64 + fr, fq * 8), boff = lds_byte(wc * 32 + fr, fq * 8);
#define PG8_SA(b, h) (((b) * 2 + (h)) * HTB)
#define PG8_SB(b, h) ((4 + (b) * 2 + (h)) * HTB)
#define PG8_STAGE(bufoff, gbase, voff) do { _Pragma("unroll") for (int _i = 0; _i < 2; ++_i) \
        __builtin_amdgcn_global_load_lds((const unsigned*)((const char*)(gbase) + (voff)[_i]), (PG8_LAS unsigned*)(lds + (bufoff) + ldsw + _i * 8192), 16, 0, 0); } while (0)
#define PG8_LDA(dst, b, h) do { _Pragma("unroll") for (int m = 0; m < 4; ++m) _Pragma("unroll") for (int k = 0; k < 2; ++k) dst[m][k] = *(const PG8_LAS bf16x8*)(lds + PG8_SA(b, h) + aoff + m * 2048 + k * 1024); } while (0)
#define PG8_LDB(dst, b, h) do { _Pragma("unroll") for (int n = 0; n < 2; ++n) _Pragma("unroll") for (int k = 0; k < 2; ++k) dst[n][k] = *(const PG8_LAS bf16x8*)(lds + PG8_SB(b, h) + boff + n * 2048 + k * 1024); } while (0)
#define PG8_MMA(ai, bj, At, Bt) do { __builtin_amdgcn_s_setprio(1); _Pragma("unroll") for (int m = 0; m < 4; ++m) _Pragma("unroll") for (int n = 0; n < 2; ++n) _Pragma("unroll") for (int k = 0; k < 2; ++k) \
        acc[ai][bj][m][n] = __builtin_amdgcn_mfma_f32_16x16x32_bf16(Bt[n][k], At[m][k], acc[ai][bj][m][n], 0, 0, 0); __builtin_amdgcn_s_setprio(0); } while (0)
#define PG8_WAIT_V(n) asm volatile("s_waitcnt vmcnt(" #n ")" ::: "memory")
#define PG8_WAIT_L(n) asm volatile("s_waitcnt lgkmcnt(" #n ")" ::: "memory")
#define PG8_BAR __builtin_amdgcn_s_barrier()
#define PG8_SCHED __builtin_amdgcn_sched_barrier(0)
    Unit cur, nxt; int ui = 0;
    if (!S.next(0, cur)) return;
    f32x4 acc[2][2][4][2];
#pragma unroll
    for (int a = 0; a < 2; ++a)
#pragma unroll
        for (int b = 0; b < 2; ++b)
#pragma unroll
            for (int m = 0; m < 4; ++m)
#pragma unroll
                for (int n = 0; n < 2; ++n) acc[a][b][m][n] = (f32x4){0.f, 0.f, 0.f, 0.f};
    bf16x8 At[4][2], B0[2][2], B1[2][2];
    const char* cA = (const char*)g.A + (size_t)cur.pm * tstep; const char* cB = (const char*)g.Bt + (size_t)cur.pn * tstep;
    S.a_ready(cur);
    if constexpr (SP2) {
        PG8_STAGE(PG8_SB(0, 0), cB, voffB); PG8_STAGE(PG8_SB(0, 1), cB + hstep, voffB); PG8_STAGE(PG8_SA(0, 0), cA, voffA); PG8_STAGE(PG8_SA(0, 1), cA + hstep, voffA);
        if (wr == 1) PG8_BAR;
        PG8_WAIT_V(2); PG8_BAR;
        PG8_STAGE(PG8_SB(1, 0), cB + kstep, voffB); PG8_STAGE(PG8_SA(1, 0), cA + kstep, voffA); PG8_STAGE(PG8_SB(1, 1), cB + hstep + kstep, voffB);
        PG8_WAIT_V(6); PG8_BAR;
    } else {
        PG8_STAGE(PG8_SB(0, 0), cB, voffB); PG8_STAGE(PG8_SA(0, 0), cA, voffA); PG8_STAGE(PG8_SB(0, 1), cB + hstep, voffB); PG8_STAGE(PG8_SA(0, 1), cA + hstep, voffA);
        if (wr == 1) PG8_BAR;
        PG8_WAIT_V(4); PG8_BAR;
        PG8_STAGE(PG8_SB(1, 0), cB + kstep, voffB); PG8_STAGE(PG8_SA(1, 0), cA + kstep, voffA); PG8_STAGE(PG8_SB(1, 1), cB + hstep + kstep, voffB);
        PG8_WAIT_V(6); PG8_BAR;
    }
    for (;;) {
        const bool has_next = S.next(ui + 1, nxt);
        const char* nA = has_next ? (const char*)g.A + (size_t)nxt.pm * tstep : cA; const char* nB = has_next ? (const char*)g.Bt + (size_t)nxt.pn * tstep : cB;
        for (int t = 0; t < nt; t += 2) {
            const bool last = (t == nt - 2);
            const char* a1 = cA + (size_t)(t + 1) * kstep;
            const char* a2 = last ? nA : cA + (size_t)(t + 2) * kstep; const char* b2 = last ? nB : cB + (size_t)(t + 2) * kstep;
            const char* a3 = a2 + kstep; const char* b3 = b2 + kstep;
            if (last && has_next) S.a_ready(nxt);
            if constexpr (SP2) {
            PG8_LDB(B0, 0, 0); PG8_LDB(B1, 0, 1); PG8_SCHED; PG8_LDA(At, 0, 0); PG8_STAGE(PG8_SA(1, 1), a1 + hstep, voffA);
            PG8_WAIT_V(8); PG8_WAIT_L(0); PG8_BAR; PG8_MMA(0, 0, At, B0); PG8_MMA(0, 1, At, B1); PG8_BAR; PG8_SCHED;
            PG8_LDA(At, 0, 1); PG8_STAGE(PG8_SB(0, 0), b2, voffB); PG8_STAGE(PG8_SB(0, 1), b2 + hstep, voffB); PG8_STAGE(PG8_SA(0, 0), a2, voffA);
            PG8_WAIT_V(8); PG8_WAIT_L(0); PG8_BAR; PG8_MMA(1, 0, At, B0); PG8_MMA(1, 1, At, B1); PG8_BAR; PG8_SCHED;
            PG8_LDB(B0, 1, 0); PG8_LDB(B1, 1, 1); PG8_SCHED; PG8_LDA(At, 1, 0); PG8_STAGE(PG8_SA(0, 1), a2 + hstep, voffA);
            PG8_WAIT_V(8); PG8_WAIT_L(0); PG8_BAR; PG8_MMA(0, 0, At, B0); PG8_MMA(0, 1, At, B1); PG8_BAR; PG8_SCHED;
            PG8_LDA(At, 1, 1); PG8_STAGE(PG8_SB(1, 0), b3, voffB); PG8_STAGE(PG8_SB(1, 1), b3 + hstep, voffB); PG8_STAGE(PG8_SA(1, 0), a3, voffA);
            PG8_WAIT_V(8); PG8_WAIT_L(0); PG8_BAR; PG8_MMA(1, 0, At, B0); PG8_MMA(1, 1, At, B1); PG8_BAR; PG8_SCHED;
            } else {
            PG8_LDB(B0, 0, 0); PG8_SCHED; PG8_LDA(At, 0, 0); PG8_STAGE(PG8_SA(1, 1), a1 + hstep, voffA);
            PG8_WAIT_L(8); PG8_BAR; PG8_WAIT_L(0); PG8_MMA(0, 0, At, B0); PG8_BAR; PG8_SCHED;
            PG8_LDB(B1, 0, 1); PG8_STAGE(PG8_SB(0, 0), b2, voffB);
            PG8_BAR; PG8_WAIT_L(0); PG8_MMA(0, 1, At, B1); PG8_BAR;
            PG8_LDA(At, 0, 1); PG8_STAGE(PG8_SA(0, 0), a2, voffA);
            PG8_BAR; PG8_WAIT_L(0); PG8_MMA(1, 0, At, B0); PG8_BAR; PG8_SCHED;
            PG8_STAGE(PG8_SB(0, 1), b2 + hstep, voffB);
            PG8_WAIT_V(6); PG8_BAR; PG8_MMA(1, 1, At, B1); PG8_BAR;
            PG8_LDB(B0, 1, 0); PG8_SCHED; PG8_LDA(At, 1, 0); PG8_STAGE(PG8_SA(0, 1), a2 + hstep, voffA);
            PG8_WAIT_L(8); PG8_BAR; PG8_WAIT_L(0); PG8_MMA(0, 0, At, B0); PG8_BAR; PG8_SCHED;
            PG8_LDB(B1, 1, 1); PG8_STAGE(PG8_SB(1, 0), b3, voffB);
            PG8_BAR; PG8_WAIT_L(0); PG8_MMA(0, 1, At, B1); PG8_BAR;
            PG8_LDA(At, 1, 1); PG8_STAGE(PG8_SA(1, 0), a3, voffA);
            PG8_BAR; PG8_WAIT_L(0); PG8_MMA(1, 0, At, B0); PG8_BAR; PG8_SCHED;
            PG8_STAGE(PG8_SB(1, 1), b3 + hstep, voffB);
            PG8_WAIT_V(6); PG8_BAR; PG8_MMA(1, 1, At, B1); PG8_BAR;
            }
        }
        if constexpr (ALIGN_EPI) { if (wr == 0) PG8_BAR; }
        if constexpr (!Epi::AFTER_DRAIN) { E(acc, cur, wr, wc, fr, fq); S.done(cur); }
        if (!has_next) break;
#pragma unroll
        for (int a = 0; a < 2; ++a)
#pragma unroll
            for (int b = 0; b < 2; ++b)
#pragma unroll
                for (int m = 0; m < 4; ++m)
#pragma unroll
                    for (int n = 0; n < 2; ++n) acc[a][b][m][n] = (f32x4){0.f, 0.f, 0.f, 0.f};
        cur = nxt; cA = nA; cB = nB; ++ui;
        if constexpr (ALIGN_EPI) { if (wr == 1) PG8_BAR; }
    }
    PG8_WAIT_V(0);
    if constexpr (!ALIGN_EPI) { if (wr == 0) PG8_BAR; }
    PG8_BAR;
    if constexpr (Epi::AFTER_DRAIN) { E.fused(acc, cur, wr, wc, fr, fq, lds, wid, lane); S.done(cur); }
#undef PG8_SA
#undef PG8_SB
#undef PG8_STAGE
#undef PG8_LDA
#undef PG8_LDB
#undef PG8_MMA
#undef PG8_WAIT_V
#undef PG8_WAIT_L
#undef PG8_BAR
#undef PG8_SCHED
}
}
using pg8::bf16_t; using pg8::bf16x8; using pg8::f32x4; using pg8::u32x4; using pg8::u32x2; using pg8::cvt_pk_bf16; using pg8::silu_f; using pg8::RMS_EPS;
#define LAS __attribute__((address_space(3)))
#define LDS_WAIT() asm volatile("s_waitcnt lgkmcnt(0)" ::: "memory")

constexpr int DM = 2048, SEQ = 2048, M = 8192, DFF = 5632, DIN = 4112, DU = 4096;
constexpr int OQ = 1024, OKK = 1536, OV = 2048, OG = 3072;
constexpr int NWAVES = 8, NTHR = 512;
constexpr float INV_DM = 1.0f / 2048.0f;

constexpr size_t MiB = 1u << 20;
constexpr size_t WS_ROWSS = 0;
constexpr size_t WS_GL = 256 * 1024;
constexpr size_t WS_DEC = 1 * MiB;
constexpr size_t WS_W1IN = 2 * MiB, WS_W1OUT = 46 * MiB, WS_WMIX = 68 * MiB, WS_WPOOL = 85 * MiB, WS_WOUT = 86 * MiB, WS_W2IN = 94 * MiB, WS_W2OUT = 138 * MiB;
constexpr size_t WS_A = 160 * MiB, WS_ACT = 192 * MiB, WS_U = 192 * MiB, WS_Y = 256 * MiB, WS_KVT = 2 * MiB, WS_END = 288 * MiB;

constexpr int RING_BYTES = 131072, LDS_BYTES = 147456;

__device__ __forceinline__ unsigned f2bf(float f) { unsigned u = __builtin_bit_cast(unsigned, f); return (u + 0x7fffu + ((u >> 16) & 1u)) >> 16; }
__device__ __forceinline__ unsigned pk2(float lo, float hi) { return f2bf(lo) | (f2bf(hi) << 16); }
__device__ __forceinline__ float bf_lo(unsigned v) { return __builtin_bit_cast(float, v << 16); }
__device__ __forceinline__ float bf_hi(unsigned v) { return __builtin_bit_cast(float, v & 0xffff0000u); }
__device__ __forceinline__ float wave_sum(float v) {
#pragma unroll
    for (int o = 1; o < 64; o <<= 1) v += __shfl_xor(v, o);
    return v;
}
#define MFMA16(a, b, c) __builtin_amdgcn_mfma_f32_16x16x32_bf16((a), (b), (c), 0, 0, 0)

__device__ __forceinline__ int swiglu_row(int n) { return n < DFF ? ((n >> 7) * 256 + (n & 127)) : (((n - DFF) >> 7) * 256 + 128 + ((n - DFF) & 127)); }
__device__ __forceinline__ void transpose_item(const float* W, int K, int N, bf16_t* WT, int mode, LAS float* scr, int item, int lane) {
    const int nblk = (N + 31) / 32, kb = item / nblk, nb = item % nblk, k0 = 64 * kb, n0 = 32 * nb;
    const int rsub = lane >> 3, n4 = (lane & 7) * 4; const bool ok = (n0 + n4) < N;
    f32x4 v[8];
#pragma unroll
    for (int i = 0; i < 8; ++i) v[i] = ok ? *(const f32x4*)(W + (size_t)(k0 + 8 * i + rsub) * N + n0 + n4) : (f32x4){0.f, 0.f, 0.f, 0.f};
#pragma unroll
    for (int i = 0; i < 8; ++i) { LAS float* d = scr + (8 * i + rsub) * 33 + n4; d[0] = v[i][0]; d[1] = v[i][1]; d[2] = v[i][2]; d[3] = v[i][3]; }
    LDS_WAIT();
    const int c = lane & 7;
#pragma unroll
    for (int j = 0; j < 4; ++j) { const int n = (lane >> 3) + 8 * j; const LAS float* s = scr + (8 * c) * 33 + n;
        u32x4 o; o.x = pk2(s[0 * 33], s[1 * 33]); o.y = pk2(s[2 * 33], s[3 * 33]); o.z = pk2(s[4 * 33], s[5 * 33]); o.w = pk2(s[6 * 33], s[7 * 33]);
        const int nn = n0 + n;
        if (nn < N) { const int drow = mode == 1 ? swiglu_row(nn) : nn; *(u32x4*)(WT + (size_t)drow * K + k0 + 8 * c) = o; } }
    LDS_WAIT();
}

struct Args { const float* in[16]; float* out; unsigned char* ws; int ph_lo, ph_hi; };

__device__ __forceinline__ void p0_prologue(const Args& a, LAS unsigned char* lds, int gw, int NGW, int lane, int wave) {
    unsigned char* ws = a.ws;
    LAS float* scr = (LAS float*)(lds + wave * 16384);
    constexpr int I_IN = (DM / 64) * (2 * DFF / 32), I_OUT = (DFF / 64) * (DM / 32), I_MIX = (DM / 64) * ((DIN + 31) / 32), I_POOL1 = (256 / 64) * (256 / 32), I_O = (DM / 64) * (DM / 32);
    constexpr int NITEMS = 2 * I_IN + 2 * I_OUT + I_MIX + 4 * I_POOL1 + I_O;
    for (int it = gw; it < NITEMS; it += NGW) {
        int r = it;
        if (r < I_IN) { transpose_item(a.in[2], DM, 2 * DFF, (bf16_t*)(ws + WS_W1IN), 1, scr, r, lane); continue; } r -= I_IN;
        if (r < I_OUT) { transpose_item(a.in[3], DFF, DM, (bf16_t*)(ws + WS_W1OUT), 0, scr, r, lane); continue; } r -= I_OUT;
        if (r < I_MIX) { transpose_item(a.in[5], DM, DIN, (bf16_t*)(ws + WS_WMIX), 0, scr, r, lane); continue; } r -= I_MIX;
        if (r < 4 * I_POOL1) { const int g = r / I_POOL1; transpose_item(a.in[6] + g * 65536, 256, 256, (bf16_t*)(ws + WS_WPOOL) + g * 65536, 0, scr, r % I_POOL1, lane); continue; } r -= 4 * I_POOL1;
        if (r < I_O) { transpose_item(a.in[11], DM, DM, (bf16_t*)(ws + WS_WOUT), 0, scr, r, lane); continue; } r -= I_O;
        if (r < I_IN) { transpose_item(a.in[13], DM, 2 * DFF, (bf16_t*)(ws + WS_W2IN), 1, scr, r, lane); continue; } r -= I_IN;
        transpose_item(a.in[14], DFF, DM, (bf16_t*)(ws + WS_W2OUT), 0, scr, r, lane);
    }
    const float* x = a.in[0]; const float* g1 = a.in[1]; bf16_t* A = (bf16_t*)(ws + WS_A); float* rowss = (float*)(ws + WS_ROWSS);
    for (int m = gw; m < M; m += NGW) {
        const f32x4* xr = (const f32x4*)(x + (size_t)m * DM) + lane; const f32x4* gr = (const f32x4*)g1 + lane;
        u32x2* o = (u32x2*)(A + (size_t)m * DM) + lane; float s = 0.f;
#pragma unroll
        for (int j = 0; j < 8; ++j) { const f32x4 v = xr[64 * j]; const f32x4 g = gr[64 * j]; s += (v[0] * v[0] + v[1] * v[1]) + (v[2] * v[2] + v[3] * v[3]);
            u32x2 w; w.x = cvt_pk_bf16(v[0] * g[0], v[1] * g[1]); w.y = cvt_pk_bf16(v[2] * g[2], v[3] * g[3]); o[64 * j] = w; }
        s = wave_sum(s);
        if (lane == 0) { rowss[m] = s; rowss[M + m] = 0.f; rowss[2 * M + m] = 0.f; rowss[3 * M + m] = 0.f; }
    }
}

__device__ __forceinline__ void gatelr_phase(const bf16_t* A, const bf16_t* WTr, const float* rowss, float* GL, LAS unsigned char* lds, int G, int tid, int wave, int lane) {
    const int fr = lane & 15, fq = lane >> 4, tg = wave >> 2, kq = wave & 3;
    LAS float* P = (LAS float*)lds;
    for (int tb = blockIdx.x; tb < M / 32; tb += G) {
        const int t0 = 32 * tb;
        const bf16_t* ap = A + (size_t)(t0 + 16 * tg + fr) * DM + kq * 512 + 8 * fq;
        const bf16_t* bp = WTr + (size_t)fr * DM + kq * 512 + 8 * fq;
        f32x4 acc = {0.f, 0.f, 0.f, 0.f};
#pragma unroll 8
        for (int ks = 0; ks < 16; ++ks) { const bf16x8 av = *(const bf16x8*)(ap + 32 * ks); const bf16x8 bv = *(const bf16x8*)(bp + 32 * ks); acc = MFMA16(av, bv, acc); }
        *(LAS f32x4*)(P + (wave * 64 + lane) * 4) = acc;
        __syncthreads();
        { const int tok = tid >> 4, r = tid & 15, tg2 = tok >> 4, tl = tok & 15, ln = r + 16 * (tl >> 2), j = tl & 3; float s = 0.f;
#pragma unroll
          for (int q = 0; q < 4; ++q) s += P[((tg2 * 4 + q) * 64 + ln) * 4 + j];
          GL[(size_t)(t0 + tok) * 16 + r] = s * rsqrtf(rowss[t0 + tok] * INV_DM + RMS_EPS); }
        __syncthreads();
    }
}

__device__ __forceinline__ void pool_task(int task, const bf16_t* U, const bf16_t* WpT, const float* pool_scale, bf16_t* Y, LAS unsigned char* lds, int tid, int wave, int lane) {
    const int tt = task >> 2, g = task & 3, T0 = 64 * tt, p0 = T0 % SEQ, w = 2 << g;
    const int fr = lane & 15, fq = lane >> 4;
    LAS bf16_t* UL = (LAS bf16_t*)lds;
    LAS bf16_t* PA = (LAS bf16_t*)(lds + 40960);
#pragma unroll
    for (int i = 0; i < 5; ++i) { const int ch = tid + 512 * i, r = ch >> 5, c16 = ch & 31, pos = p0 - 16 + r;
        u32x4 v = {0u, 0u, 0u, 0u};
        if (pos >= 0) v = *(const u32x4*)(U + (size_t)(T0 - 16 + r) * DU + g * 256 + c16 * 8);
        *(LAS u32x4*)(UL + r * 256 + c16 * 8) = v; }
    __syncthreads();
    {
        const int cp = tid & 127, tq = tid >> 7, i0 = 16 * tq;
        const LAS unsigned* UL32 = (const LAS unsigned*)UL; LAS unsigned* PA32 = (LAS unsigned*)PA;
        float s0 = 0.f, s1 = 0.f;
        for (int s = i0 - w + 1; s < i0; ++s) { const unsigned v = UL32[(s + 16) * 128 + cp]; s0 += bf_lo(v); s1 += bf_hi(v); }
        for (int i = i0; i < i0 + 16; ++i) {
            const unsigned v = UL32[(i + 16) * 128 + cp]; const float a0 = bf_lo(v), a1 = bf_hi(v);
            s0 += a0; s1 += a1;
            const int pos = p0 + i; const int cnt = (pos + 1) < w ? (pos + 1) : w; const float inv = 1.0f / (float)cnt;
            PA32[i * 132 + cp] = cvt_pk_bf16(s0 * inv - a0, s1 * inv - a1);
            const unsigned o = UL32[(i - w + 1 + 16) * 128 + cp]; s0 -= bf_lo(o); s1 -= bf_hi(o);
        }
    }
    __syncthreads();
    f32x4 acc[4][2];
#pragma unroll
    for (int mt = 0; mt < 4; ++mt)
#pragma unroll
        for (int nt = 0; nt < 2; ++nt) acc[mt][nt] = (f32x4){0.f, 0.f, 0.f, 0.f};
    const bf16_t* wp = WpT + (size_t)g * 65536 + (size_t)(32 * wave + fr) * 256 + 8 * fq;
#pragma unroll
    for (int ks = 0; ks < 8; ++ks) {
        bf16x8 wf[2];
#pragma unroll
        for (int nt = 0; nt < 2; ++nt) wf[nt] = *(const bf16x8*)(wp + nt * 16 * 256 + 32 * ks);
#pragma unroll
        for (int mt = 0; mt < 4; ++mt) { const bf16x8 af = *(const LAS bf16x8*)(PA + (16 * mt + fr) * 264 + 32 * ks + 8 * fq);
#pragma unroll
            for (int nt = 0; nt < 2; ++nt) acc[mt][nt] = MFMA16(wf[nt], af, acc[mt][nt]); }
    }
#pragma unroll
    for (int nt = 0; nt < 2; ++nt) { const int n = 32 * wave + 16 * nt + 4 * fq; const f32x4 sc = *(const f32x4*)(pool_scale + g * 256 + n);
#pragma unroll
        for (int mt = 0; mt < 4; ++mt) { const f32x4 v = acc[mt][nt] * sc; u32x2 o; o.x = cvt_pk_bf16(v[0], v[1]); o.y = cvt_pk_bf16(v[2], v[3]);
            *(u32x2*)(Y + (size_t)(T0 + 16 * mt + fr) * DM + g * 256 + n) = o; } }
    __syncthreads();
}

__device__ __forceinline__ void gla_bcum(const float* GL, const float* w_alpha, const float* b_alpha, int T0, int h, LAS float* GLs, LAS float* BC, LAS float* SEG, int tid) {
    for (int i = tid; i < 1024; i += NTHR) GLs[i] = GL[(size_t)T0 * 16 + i];
    const int d = tid & 127, q = tid >> 7;
    float wa[16];
#pragma unroll
    for (int r = 0; r < 16; ++r) wa[r] = w_alpha[r * 512 + h * 128 + d];
    const float ba = b_alpha[h * 128 + d];
    __syncthreads();
    float c = 0.f;
#pragma unroll 4
    for (int tt = 0; tt < 16; ++tt) { const int t = 16 * q + tt; float z = ba;
#pragma unroll
        for (int r = 0; r < 16; ++r) z += GLs[t * 16 + r] * wa[r];
        const float ls = fminf(z, 0.f) - log1pf(expf(-fabsf(z)));
        c += ls * 0.0625f; BC[t * 128 + d] = c; }
    SEG[q * 128 + d] = c;
    __syncthreads();
    float off = 0.f;
    for (int qq = 0; qq < q; ++qq) off += SEG[qq * 128 + d];
    if (q > 0) {
#pragma unroll 4
        for (int tt = 0; tt < 16; ++tt) BC[(16 * q + tt) * 128 + d] += off; }
    __syncthreads();
}
__device__ __forceinline__ u32x4 pack8(const unsigned (&b)[8]) { u32x4 o; o.x = b[0] | (b[1] << 16); o.y = b[2] | (b[3] << 16); o.z = b[4] | (b[5] << 16); o.w = b[6] | (b[7] << 16); return o; }
__device__ __forceinline__ void gla_stage_vt(const bf16_t* U, int T0, int h, LAS bf16_t* VT, int tid) {
    const int dvp = tid & 127, cgrp = tid >> 7;
#pragma unroll
    for (int hf = 0; hf < 2; ++hf) { const int c8 = 16 * cgrp + 8 * hf; unsigned a[8], b[8];
#pragma unroll
        for (int cc = 0; cc < 8; ++cc) { const unsigned vv = *(const unsigned*)(U + (size_t)(T0 + c8 + cc) * DU + OV + h * 256 + 2 * dvp); a[cc] = vv & 0xffffu; b[cc] = vv >> 16; }
        *(LAS u32x4*)(VT + (2 * dvp) * 72 + c8) = pack8(a); *(LAS u32x4*)(VT + (2 * dvp + 1) * 72 + c8) = pack8(b); }
}
constexpr int GL_OFF = 0, BC_OFF = 4096, SEG_OFF = 36864;
__device__ __forceinline__ void gla_kv_task(int task, const bf16_t* U, const float* GL, const float* w_alpha, const float* b_alpha, float* KVT, float* DEC, LAS unsigned char* lds, int tid, int wave, int lane) {
    const int b = task >> 7, h = (task >> 5) & 3, n = task & 31, T0 = b * SEQ + n * 64;
    const int fr = lane & 15, fq = lane >> 4;
    LAS float* GLs = (LAS float*)(lds + GL_OFF); LAS float* BC = (LAS float*)(lds + BC_OFF); LAS float* SEG = (LAS float*)(lds + SEG_OFF);
    LAS bf16_t* KT = (LAS bf16_t*)(lds + 38912);
    LAS bf16_t* VT = (LAS bf16_t*)(lds + 57344);
    gla_bcum(GL, w_alpha, b_alpha, T0, h, GLs, BC, SEG, tid);
    { const int dp = tid & 63, cg8 = tid >> 6; const float bl0 = BC[63 * 128 + 2 * dp], bl1 = BC[63 * 128 + 2 * dp + 1]; unsigned k0[8], k1[8];
#pragma unroll
      for (int cc = 0; cc < 8; ++cc) { const int c = 8 * cg8 + cc; const unsigned kv = *(const unsigned*)(U + (size_t)(T0 + c) * DU + OKK + h * 128 + 2 * dp);
          k0[cc] = f2bf(bf_lo(kv) * expf(bl0 - BC[c * 128 + 2 * dp])); k1[cc] = f2bf(bf_hi(kv) * expf(bl1 - BC[c * 128 + 2 * dp + 1])); }
      *(LAS u32x4*)(KT + (2 * dp) * 72 + 8 * cg8) = pack8(k0); *(LAS u32x4*)(KT + (2 * dp + 1) * 72 + 8 * cg8) = pack8(k1); }
    gla_stage_vt(U, T0, h, VT, tid);
    __syncthreads();
    f32x4 acc[2][8];
#pragma unroll
    for (int mt = 0; mt < 2; ++mt)
#pragma unroll
        for (int nt = 0; nt < 8; ++nt) acc[mt][nt] = (f32x4){0.f, 0.f, 0.f, 0.f};
#pragma unroll
    for (int ks = 0; ks < 2; ++ks) { bf16x8 vf[2];
#pragma unroll
        for (int mt = 0; mt < 2; ++mt) vf[mt] = *(const LAS bf16x8*)(VT + (32 * wave + 16 * mt + fr) * 72 + 32 * ks + 8 * fq);
#pragma unroll
        for (int nt = 0; nt < 8; ++nt) { const bf16x8 kf = *(const LAS bf16x8*)(KT + (16 * nt + fr) * 72 + 32 * ks + 8 * fq);
#pragma unroll
            for (int mt = 0; mt < 2; ++mt) acc[mt][nt] = MFMA16(kf, vf[mt], acc[mt][nt]); } }
    float* kvp = KVT + (size_t)task * 32768;
#pragma unroll
    for (int mt = 0; mt < 2; ++mt)
#pragma unroll
        for (int nt = 0; nt < 8; ++nt) *(f32x4*)(kvp + (32 * wave + 16 * mt + fr) * 128 + 16 * nt + 4 * fq) = acc[mt][nt];
    if (tid < 128) DEC[task * 128 + tid] = expf(BC[63 * 128 + tid]);
    __syncthreads();
}
__device__ __forceinline__ void gla_scan_phase(float* KVT, const float* DEC, int G, int tid) {
    for (int e = blockIdx.x * NTHR + tid; e < 16 * 8192; e += G * NTHR) {
        const int bh = e >> 13, e4 = e & 8191, dk0 = (e4 * 4) & 127;
        f32x4 st = {0.f, 0.f, 0.f, 0.f};
        for (int n0 = 0; n0 < 32; n0 += 8) { f32x4 kv[8], dc[8];
#pragma unroll
            for (int j = 0; j < 8; ++j) { kv[j] = *(const f32x4*)(KVT + (size_t)(bh * 32 + n0 + j) * 32768 + e4 * 4); dc[j] = *(const f32x4*)(DEC + (bh * 32 + n0 + j) * 128 + dk0); }
#pragma unroll
            for (int j = 0; j < 8; ++j) { *(f32x4*)(KVT + (size_t)(bh * 32 + n0 + j) * 32768 + e4 * 4) = st; st = st * dc[j] + kv[j]; } }
    }
}
__device__ __forceinline__ void gla_out_task(int task, const bf16_t* U, const float* GL, const float* w_alpha, const float* b_alpha, const float* KVT, const float* gla_norm, bf16_t* Y, LAS unsigned char* lds, int tid, int wave, int lane) {
    const int b = task >> 7, h = (task >> 5) & 3, n = task & 31, T0 = b * SEQ + n * 64;
    const int fr = lane & 15, fq = lane >> 4;
    LAS float* GLs = (LAS float*)(lds + GL_OFF); LAS float* BC = (LAS float*)(lds + BC_OFF); LAS float* SEG = (LAS float*)(lds + SEG_OFF);
    LAS bf16_t* QD = (LAS bf16_t*)(lds + 38912);
    LAS bf16_t* KI = (LAS bf16_t*)(lds + 56320);
    LAS bf16_t* SC = (LAS bf16_t*)(lds + 73728);
    LAS bf16_t* VT = (LAS bf16_t*)(lds + 82944);
    LAS float* RS = (LAS float*)(lds + 119808);
    gla_bcum(GL, w_alpha, b_alpha, T0, h, GLs, BC, SEG, tid);
    { const int dp = tid & 63, cg8 = tid >> 6; LAS unsigned* QD32 = (LAS unsigned*)QD; LAS unsigned* KI32 = (LAS unsigned*)KI; const float qs = 0.08838834764831845f;
#pragma unroll
      for (int cc = 0; cc < 8; ++cc) { const int c = 8 * cg8 + cc; const bf16_t* up = U + (size_t)(T0 + c) * DU + h * 128 + 2 * dp;
          const unsigned q2 = *(const unsigned*)(up + OQ), k2 = *(const unsigned*)(up + OKK); const float b0 = BC[c * 128 + 2 * dp], b1 = BC[c * 128 + 2 * dp + 1];
          QD32[c * 68 + dp] = cvt_pk_bf16(bf_lo(q2) * qs * expf(b0), bf_hi(q2) * qs * expf(b1));
          KI32[c * 68 + dp] = cvt_pk_bf16(bf_lo(k2) * expf(-b0), bf_hi(k2) * expf(-b1)); } }
    gla_stage_vt(U, T0, h, VT, tid);
    __syncthreads();
    { const int it = wave & 3, jp = wave >> 2;
#pragma unroll
      for (int jj = 0; jj < 2; ++jj) { const int jt = 2 * jp + jj; f32x4 s = {0.f, 0.f, 0.f, 0.f};
          if (jt <= it) {
#pragma unroll
              for (int ks = 0; ks < 4; ++ks) { const bf16x8 kf = *(const LAS bf16x8*)(KI + (16 * jt + fr) * 136 + 32 * ks + 8 * fq); const bf16x8 qf = *(const LAS bf16x8*)(QD + (16 * it + fr) * 136 + 32 * ks + 8 * fq);
                  s = MFMA16(kf, qf, s); } }
          const int i = 16 * it + fr, j0 = 16 * jt + 4 * fq;
          u32x2 o; o.x = cvt_pk_bf16(j0 + 0 <= i ? s[0] : 0.f, j0 + 1 <= i ? s[1] : 0.f); o.y = cvt_pk_bf16(j0 + 2 <= i ? s[2] : 0.f, j0 + 3 <= i ? s[3] : 0.f);
          *(LAS u32x2*)(SC + i * 72 + j0) = o; } }
    __syncthreads();
    f32x4 acc[4][2];
#pragma unroll
    for (int mt = 0; mt < 4; ++mt)
#pragma unroll
        for (int nt = 0; nt < 2; ++nt) acc[mt][nt] = (f32x4){0.f, 0.f, 0.f, 0.f};
#pragma unroll
    for (int ks = 0; ks < 2; ++ks) { bf16x8 vf[2];
#pragma unroll
        for (int nt = 0; nt < 2; ++nt) vf[nt] = *(const LAS bf16x8*)(VT + (32 * wave + 16 * nt + fr) * 72 + 32 * ks + 8 * fq);
#pragma unroll
        for (int mt = 0; mt < 4; ++mt) { const bf16x8 sf = *(const LAS bf16x8*)(SC + (16 * mt + fr) * 72 + 32 * ks + 8 * fq);
#pragma unroll
            for (int nt = 0; nt < 2; ++nt) acc[mt][nt] = MFMA16(vf[nt], sf, acc[mt][nt]); } }
    const float* stp = KVT + (size_t)task * 32768;
#pragma unroll
    for (int ks = 0; ks < 4; ++ks) { bf16x8 sf[2];
#pragma unroll
        for (int nt = 0; nt < 2; ++nt) { const float* p = stp + (32 * wave + 16 * nt + fr) * 128 + 32 * ks + 8 * fq; const f32x4 lo = *(const f32x4*)p, hi = *(const f32x4*)(p + 4);
            u32x4 w; w.x = cvt_pk_bf16(lo[0], lo[1]); w.y = cvt_pk_bf16(lo[2], lo[3]); w.z = cvt_pk_bf16(hi[0], hi[1]); w.w = cvt_pk_bf16(hi[2], hi[3]); sf[nt] = __builtin_bit_cast(bf16x8, w); }
#pragma unroll
        for (int mt = 0; mt < 4; ++mt) { const bf16x8 qf = *(const LAS bf16x8*)(QD + (16 * mt + fr) * 136 + 32 * ks + 8 * fq);
#pragma unroll
            for (int nt = 0; nt < 2; ++nt) acc[mt][nt] = MFMA16(sf[nt], qf, acc[mt][nt]); } }
#pragma unroll
    for (int mt = 0; mt < 4; ++mt) { float s = 0.f;
#pragma unroll
        for (int nt = 0; nt < 2; ++nt) { const f32x4 v = acc[mt][nt]; s += (v[0] * v[0] + v[1] * v[1]) + (v[2] * v[2] + v[3] * v[3]); }
        s += __shfl_xor(s, 16); s += __shfl_xor(s, 32);
        if (fq == 0) RS[wave * 64 + 16 * mt + fr] = s; }
    __syncthreads();
#pragma unroll
    for (int mt = 0; mt < 4; ++mt) { float tot = 0.f;
#pragma unroll
        for (int w8 = 0; w8 < 8; ++w8) tot += RS[w8 * 64 + 16 * mt + fr];
        const float rstd = rsqrtf(tot * (1.0f / 256.0f) + RMS_EPS); const int tok = T0 + 16 * mt + fr;
#pragma unroll
        for (int nt = 0; nt < 2; ++nt) { const int dv = 32 * wave + 16 * nt + 4 * fq; const f32x4 gn = *(const f32x4*)(gla_norm + dv);
            const u32x2 g2 = *(const u32x2*)(U + (size_t)tok * DU + OG + h * 256 + dv); const f32x4 v = acc[mt][nt] * rstd * gn;
            u32x2 o; o.x = cvt_pk_bf16(v[0] * silu_f(bf_lo(g2.x)), v[1] * silu_f(bf_hi(g2.x))); o.y = cvt_pk_bf16(v[2] * silu_f(bf_lo(g2.y)), v[3] * silu_f(bf_hi(g2.y)));
            *(u32x2*)(Y + (size_t)tok * DM + 1024 + h * 256 + dv) = o; } }
    __syncthreads();
}

__global__ void __launch_bounds__(NTHR, 2) mk_fwd(Args args) {
    extern __shared__ __attribute__((aligned(16))) unsigned char lds_raw[];
    LAS unsigned char* lds = (LAS unsigned char*)lds_raw;
    cg::grid_group grid = cg::this_grid();
    const int tid = threadIdx.x, lane = tid & 63, wave = __builtin_amdgcn_readfirstlane(tid >> 6);
    const int G = gridDim.x, bx = blockIdx.x;
    const int vcu = (G % 8 == 0) ? (bx % 8) * (G / 8) + bx / 8 : bx;
    const int gw = vcu * NWAVES + wave, NGW = G * NWAVES;
    unsigned char* ws = args.ws;
    float* rowss = (float*)(ws + WS_ROWSS); float* GL = (float*)(ws + WS_GL); float* DEC = (float*)(ws + WS_DEC);
    bf16_t* A = (bf16_t*)(ws + WS_A); bf16_t* ACT = (bf16_t*)(ws + WS_ACT); bf16_t* U = (bf16_t*)(ws + WS_U); bf16_t* Y = (bf16_t*)(ws + WS_Y); float* KVT = (float*)(ws + WS_KVT);
    const int lo = args.ph_lo, hi = args.ph_hi;
#define IN(k) (lo <= (k) && (k) < hi)
#define SEAM(k) do { if (IN(k) && IN((k) + 1)) grid.sync(); } while (0)

    if (IN(0)) { p0_prologue(args, lds, gw, NGW, lane, wave); }
    SEAM(0);
    if (IN(1)) { pg8::Gemm g{A, (const bf16_t*)(ws + WS_W1IN), M, 2 * DFF, DM}; pg8::StaticOrder S; S.init(M, 2 * DFF, G, bx);
        pg8::EpiSwiGLU E{ACT, DFF, rowss, INV_DM};
        pg8::gemm_phase<pg8::EpiSwiGLU, pg8::StaticOrder, true, true>(lds, g, S, E); }
    SEAM(1);
    if (IN(2)) { pg8::Gemm g{ACT, (const bf16_t*)(ws + WS_W1OUT), M, DM, DFF}; pg8::StaticOrder S; S.init(M, DM, G, bx);
        pg8::EpiResid E{args.in[0], args.out, 0.5f, A, args.in[4], rowss + M};
        pg8::gemm_phase<pg8::EpiResid, pg8::StaticOrder, true, true>(lds, g, S, E); }
    SEAM(2);
    if (IN(3)) { gatelr_phase(A, (const bf16_t*)(ws + WS_WMIX) + (size_t)DU * DM, rowss + M, GL, lds, G, tid, wave, lane);
        pg8::Gemm g{A, (const bf16_t*)(ws + WS_WMIX), M, DU, DM}; pg8::StaticOrder S; S.init(M, DU, G, bx);
        pg8::EpiScaleBf16 E{U, DU, rowss + M, INV_DM};
        pg8::gemm_phase<pg8::EpiScaleBf16, pg8::StaticOrder, true, true>(lds, g, S, E); }
    SEAM(3);
    if (IN(4)) { for (int t = bx; t < 1024; t += G) {
            if (t < 512) gla_kv_task(t, U, GL, args.in[8], args.in[9], KVT, DEC, lds, tid, wave, lane);
            else pool_task(t - 512, U, (const bf16_t*)(ws + WS_WPOOL), args.in[7], Y, lds, tid, wave, lane); } }
    SEAM(4);
    if (IN(5)) { gla_scan_phase(KVT, DEC, G, tid); }
    SEAM(5);
    if (IN(6)) { for (int t = bx; t < 512; t += G) gla_out_task(t, U, GL, args.in[8], args.in[9], KVT, args.in[10], Y, lds, tid, wave, lane); }
    SEAM(6);
    if (IN(7)) { pg8::Gemm g{Y, (const bf16_t*)(ws + WS_WOUT), M, DM, DM}; pg8::StaticOrder S; S.init(M, DM, G, bx);
        pg8::EpiResid E{args.out, args.out, 1.0f, A, args.in[12], rowss + 2 * M};
        pg8::gemm_phase<pg8::EpiResid, pg8::StaticOrder, true, true>(lds, g, S, E); }
    SEAM(7);
    if (IN(8)) { pg8::Gemm g{A, (const bf16_t*)(ws + WS_W2IN), M, 2 * DFF, DM}; pg8::StaticOrder S; S.init(M, 2 * DFF, G, bx);
        pg8::EpiSwiGLU E{ACT, DFF, rowss + 2 * M, INV_DM};
        pg8::gemm_phase<pg8::EpiSwiGLU, pg8::StaticOrder, true, true>(lds, g, S, E); }
    SEAM(8);
    if (IN(9)) { pg8::Gemm g{ACT, (const bf16_t*)(ws + WS_W2OUT), M, DM, DFF}; pg8::StaticOrder S; S.init(M, DM, G, bx);
        pg8::EpiResid E{args.out, args.out, 0.5f, nullptr, nullptr, rowss + 3 * M};
        pg8::gemm_phase<pg8::EpiResid, pg8::StaticOrder, true, true>(lds, g, S, E); }
    SEAM(9);
    if (IN(10)) { const float* fn = args.in[15];
        for (int m = gw; m < M; m += NGW) { f32x4* orow = (f32x4*)(args.out + (size_t)m * DM) + lane; const f32x4* gr = (const f32x4*)fn + lane;
            const float rs = rsqrtf(rowss[3 * M + m] * INV_DM + RMS_EPS);
#pragma unroll
            for (int j = 0; j < 8; ++j) { const f32x4 v = orow[64 * j]; orow[64 * j] = v * rs * gr[64 * j]; } } }
#undef IN
#undef SEAM
}

#ifndef MK_N_LAUNCHES
#define MK_N_LAUNCHES 1
#endif
extern "C" void kernel_launch(void* const* d_in, const int* in_sizes, int n_in, void* d_out, int out_size, void* d_ws, size_t ws_size, hipStream_t stream) {
    static int grid = 0;
    if (grid == 0) {
        if (n_in != 16 || out_size != M * DM || ws_size < WS_END) { fprintf(stderr, "kernel_launch: unexpected shapes (n_in %d out %d ws %zu)\n", n_in, out_size, ws_size); grid = -1; return; }
        int dev = 0, cus = 0, per_cu = 0;
        if (hipGetDevice(&dev) != hipSuccess || hipDeviceGetAttribute(&cus, hipDeviceAttributeMultiprocessorCount, dev) != hipSuccess) { grid = -1; return; }
        if (hipFuncSetAttribute((const void*)mk_fwd, hipFuncAttributeMaxDynamicSharedMemorySize, LDS_BYTES) != hipSuccess) { fprintf(stderr, "kernel_launch: hipFuncSetAttribute failed\n"); grid = -1; return; }
        if (hipOccupancyMaxActiveBlocksPerMultiprocessor(&per_cu, (const void*)mk_fwd, NTHR, LDS_BYTES) != hipSuccess || per_cu < 1) { fprintf(stderr, "kernel_launch: occupancy query says %d\n", per_cu); per_cu = 1; }
        (void)hipGetLastError();
        grid = cus;
    }
    if (grid < 0) return;
    Args a{};
    for (int i = 0; i < 16; ++i) a.in[i] = (const float*)d_in[i];
    a.out = (float*)d_out; a.ws = (unsigned char*)d_ws;
#if MK_N_LAUNCHES == 1
    a.ph_lo = 0; a.ph_hi = 11;
    void* kargs[] = {&a};
    hipError_t e = hipLaunchCooperativeKernel((const void*)mk_fwd, dim3(grid), dim3(NTHR), kargs, LDS_BYTES, stream);
    if (e != hipSuccess) fprintf(stderr, "kernel_launch: cooperative launch failed: %s (grid %d)\n", hipGetErrorString(e), grid);
#else
    for (int p = 0; p < 11; ++p) { a.ph_lo = p; a.ph_hi = p + 1; hipLaunchKernelGGL(mk_fwd, dim3(grid), dim3(NTHR), LDS_BYTES, stream, a); }
#endif
}
```

```cpp
#include <hip/hip_runtime.h>
#include <hip/hip_cooperative_groups.h>
#include <cstdio>
#include <cstdint>
namespace cg = cooperative_groups;
#define B_FAST 1
#define B_QK 1
#define B_BF16 0
namespace pg8 {
#define PG8_LAS __attribute__((address_space(3)))
typedef unsigned short bf16_t;
typedef short bf16x8 __attribute__((ext_vector_type(8)));
typedef float f32x4 __attribute__((ext_vector_type(4)));
typedef unsigned u32x4 __attribute__((ext_vector_type(4)));
constexpr int BM = 256, BK = 64, HALF = 128, HTB = HALF * BK * 2  , STAGE_BYTES = 8 * HTB, NXCD = 8, WGM = 8;

__host__ __device__ __forceinline__ int lds_byte(int r, int c) { const int st = (r >> 4) * 2 + (c >> 5), rr = r & 15, cc = c & 31, ob = rr * 64 + cc * 2; return st * 1024 + (ob ^ (((ob >> 9) & 1) << 5)); }
__host__ __device__ __forceinline__ void stage_rc(int b, int& R, int& C) { const int st = b / 1024, sb = b % 1024, swz = sb ^ (((sb >> 9) & 1) << 5); R = (st >> 1) * 16 + swz / 64; C = (st & 1) * 32 + (swz % 64) / 2; }
__host__ __device__ __forceinline__ int perm32(int rho) { const int n = rho >> 4, i = rho & 15; return 8 * (i >> 2) + 4 * n + (i & 3); }

struct Unit { int pm, pn; };
struct Gemm { const bf16_t* A; const bf16_t* Bt; int M, N, K; };

struct StaticOrder {
    int nM, nN, nwg, G, c;
    __host__ __device__ void init(int M, int N, int G_, int c_) { nM = M / BM; nN = N / BM; nwg = nM * nN; G = G_; c = c_; }
    __host__ __device__ bool next(int i, Unit& u) const {
        const long L = (long)i * G + c; if (L >= nwg) return false;
        int wgid = (int)L; { const int q = nwg / NXCD, r = nwg % NXCD, xcd = wgid % NXCD, off = wgid / NXCD; wgid = (xcd < r ? xcd * (q + 1) : r * (q + 1) + (xcd - r) * q) + off; }
        const int nig = WGM * nN, gid = wgid / nig, fm = gid * WGM, gsz = (nM - fm) < WGM ? (nM - fm) : WGM;
        u.pm = fm + ((wgid % nig) % gsz); u.pn = (wgid % nig) / gsz; return true;
    }
    __device__ __forceinline__ void a_ready(const Unit&) const {}
    __device__ __forceinline__ void done(const Unit&) const {}
};

__device__ __forceinline__ unsigned cvt_pk_bf16(float lo, float hi) { unsigned r; asm volatile("v_cvt_pk_bf16_f32 %0, %1, %2" : "=v"(r) : "v"(lo), "v"(hi)); return r; }
typedef float f32x2 __attribute__((ext_vector_type(2)));
constexpr float RMS_EPS = 1e-6f;
typedef unsigned u32x2 __attribute__((ext_vector_type(2)));
__device__ __forceinline__ float silu_f(float g) { return g * __builtin_amdgcn_rcpf(1.0f + __builtin_amdgcn_exp2f(-1.44269504089f * g)); }

struct EpiSwiGLU {
    static constexpr bool PERM = true, AFTER_DRAIN = false;
    bf16_t* O; int ldc; const float* rowss; float inv_d;
    __device__ __forceinline__ void operator()(const f32x4 (&acc)[2][2][4][2], const Unit& u, int wr, int wc, int fr, int fq) const {
        const int row0 = u.pm * BM + wr * 64 + fr, col0 = u.pn * HALF + wc * 32 + 8 * fq;
#pragma unroll
        for (int ai = 0; ai < 2; ++ai)
#pragma unroll
            for (int m = 0; m < 4; ++m) {
                const int row = row0 + ai * HALF + m * 16;
                const float rs = rsqrtf(rowss[row] * inv_d + RMS_EPS);
                const f32x4 g0 = acc[ai][0][m][0] * rs, g1 = acc[ai][0][m][1] * rs, u0 = acc[ai][1][m][0] * rs, u1 = acc[ai][1][m][1] * rs;
                u32x4 w;
                w.x = cvt_pk_bf16(silu_f(g0[0]) * u0[0], silu_f(g0[1]) * u0[1]); w.y = cvt_pk_bf16(silu_f(g0[2]) * u0[2], silu_f(g0[3]) * u0[3]);
                w.z = cvt_pk_bf16(silu_f(g1[0]) * u1[0], silu_f(g1[1]) * u1[1]); w.w = cvt_pk_bf16(silu_f(g1[2]) * u1[2], silu_f(g1[3]) * u1[3]);
                *(u32x4*)(O + (size_t)row * ldc + col0) = w;
            }
    }
};
struct EpiScaleBf16 {
    static constexpr bool PERM = true, AFTER_DRAIN = false;
    bf16_t* O; int ldc; const float* rowss; float inv_d;
    __device__ __forceinline__ void operator()(const f32x4 (&acc)[2][2][4][2], const Unit& u, int wr, int wc, int fr, int fq) const {
        const int row0 = u.pm * BM + wr * 64 + fr, col0 = u.pn * BM + wc * 32 + 8 * fq;
#pragma unroll
        for (int ai = 0; ai < 2; ++ai)
#pragma unroll
            for (int m = 0; m < 4; ++m) {
                const int row = row0 + ai * HALF + m * 16;
                const float rs = rsqrtf(rowss[row] * inv_d + RMS_EPS);
                bf16_t* rowp = O + (size_t)row * ldc + col0;
#pragma unroll
                for (int bj = 0; bj < 2; ++bj) { const f32x4 v0 = acc[ai][bj][m][0] * rs, v1 = acc[ai][bj][m][1] * rs;
                    u32x4 w; w.x = cvt_pk_bf16(v0[0], v0[1]); w.y = cvt_pk_bf16(v0[2], v0[3]); w.z = cvt_pk_bf16(v1[0], v1[1]); w.w = cvt_pk_bf16(v1[2], v1[3]);
                    *(u32x4*)(rowp + bj * HALF) = w; }
            }
    }
};
struct EpiResid {
    static constexpr bool PERM = false, AFTER_DRAIN = false;
    const float* base; float* out; float alpha; bf16_t* HG; const float* gvec; float* rowss_out;
    __device__ __forceinline__ void operator()(const f32x4 (&acc)[2][2][4][2], const Unit& u, int wr, int wc, int fr, int fq) const {
        const int row0 = u.pm * BM + wr * 64 + fr, col0 = u.pn * BM + wc * 32 + 4 * fq;
        f32x4 gv[2][2];
#pragma unroll
        for (int bj = 0; bj < 2; ++bj)
#pragma unroll
            for (int n = 0; n < 2; ++n) gv[bj][n] = HG ? *(const f32x4*)(gvec + col0 + bj * HALF + n * 16) : (f32x4){0.f, 0.f, 0.f, 0.f};
#pragma unroll
        for (int ai = 0; ai < 2; ++ai)
#pragma unroll
            for (int m = 0; m < 4; ++m) {
                const int row = row0 + ai * HALF + m * 16; const size_t off = (size_t)row * 2048 + col0; float ss = 0.f;
#pragma unroll
                for (int bj = 0; bj < 2; ++bj)
#pragma unroll
                    for (int n = 0; n < 2; ++n) {
                        const f32x4 b = *(const f32x4*)(base + off + bj * HALF + n * 16);
                        const f32x4 h = b + acc[ai][bj][m][n] * alpha;
                        *(f32x4*)(out + off + bj * HALF + n * 16) = h;
                        ss += (h[0] * h[0] + h[1] * h[1]) + (h[2] * h[2] + h[3] * h[3]);
                        if (HG) { const f32x4 t = h * gv[bj][n]; u32x2 w; w.x = cvt_pk_bf16(t[0], t[1]); w.y = cvt_pk_bf16(t[2], t[3]); *(u32x2*)(HG + off + bj * HALF + n * 16) = w; }
                    }
                ss += __shfl_xor(ss, 16); ss += __shfl_xor(ss, 32);
                if (fq == 0) atomicAdd(rowss_out + row, ss);
                if (m & 1) asm volatile("" ::: "memory");
            }
    }
};
template <class Epi, class Sched, bool ALIGN_EPI = false, bool SP2 = false>
__device__ __forceinline__ void gemm_phase(PG8_LAS unsigned char* lds, const Gemm g, const Sched& S, const Epi& E) {
    const int tid = threadIdx.x, wid = __builtin_amdgcn_readfirstlane(tid >> 6), lane = tid & 63, wr = wid >> 2, wc = wid & 3, fr = lane & 15, fq = lane >> 4;
    const int K = g.K, nt = K / BK;
    unsigned voffA[2], voffB[2];
#pragma unroll
    for (int i = 0; i < 2; ++i) { int R, C; stage_rc(tid * 16 + i * 8192, R, C); const int Rb = Epi::PERM ? ((R & ~31) + perm32(R & 31)) : R;
        voffA[i] = (unsigned)(R * K + C) * 2u; voffB[i] = (unsigned)(Rb * K + C) * 2u; }
    const size_t kstep = (size_t)(BK * 2);
    const size_t hstep = (size_t)HALF * K * 2;
    const size_t tstep = 2 * hstep;
    const unsigned ldsw = (unsigned)wid * 1024u;
    const int aoff = lds_byte(wr * 64 + fr, fq * 8), boff = lds_byte(wc * 32 + fr, fq * 8);
#define PG8_SA(b, h) (((b) * 2 + (h)) * HTB)
#define PG8_SB(b, h) ((4 + (b) * 2 + (h)) * HTB)
#define PG8_STAGE(bufoff, gbase, voff) do { _Pragma("unroll") for (int _i = 0; _i < 2; ++_i) \
        __builtin_amdgcn_global_load_lds((const unsigned*)((const char*)(gbase) + (voff)[_i]), (PG8_LAS unsigned*)(lds + (bufoff) + ldsw + _i * 8192), 16, 0, 0); } while (0)
#define PG8_LDA(dst, b, h) do { _Pragma("unroll") for (int m = 0; m < 4; ++m) _Pragma("unroll") for (int k = 0; k < 2; ++k) dst[m][k] = *(const PG8_LAS bf16x8*)(lds + PG8_SA(b, h) + aoff + m * 2048 + k * 1024); } while (0)
#define PG8_LDB(dst, b, h) do { _Pragma("unroll") for (int n = 0; n < 2; ++n) _Pragma("unroll") for (int k = 0; k < 2; ++k) dst[n][k] = *(const PG8_LAS bf16x8*)(lds + PG8_SB(b, h) + boff + n * 2048 + k * 1024); } while (0)
#define PG8_MMA(ai, bj, At, Bt) do { __builtin_amdgcn_s_setprio(1); _Pragma("unroll") for (int m = 0; m < 4; ++m) _Pragma("unroll") for (int n = 0; n < 2; ++n) _Pragma("unroll") for (int k = 0; k < 2; ++k) \
        acc[ai][bj][m][n] = __builtin_amdgcn_mfma_f32_16x16x32_bf16(Bt[n][k], At[m][k], acc[ai][bj][m][n], 0, 0, 0); __builtin_amdgcn_s_setprio(0); } while (0)
#define PG8_WAIT_V(n) asm volatile("s_waitcnt vmcnt(" #n ")" ::: "memory")
#define PG8_WAIT_L(n) asm volatile("s_waitcnt lgkmcnt(" #n ")" ::: "memory")
#define PG8_BAR __builtin_amdgcn_s_barrier()
#define PG8_SCHED __builtin_amdgcn_sched_barrier(0)
    Unit cur, nxt; int ui = 0;
    if (!S.next(0, cur)) return;
    f32x4 acc[2][2][4][2];
#pragma unroll
    for (int a = 0; a < 2; ++a)
#pragma unroll
        for (int b = 0; b < 2; ++b)
#pragma unroll
            for (int m = 0; m < 4; ++m)
#pragma unroll
                for (int n = 0; n < 2; ++n) acc[a][b][m][n] = (f32x4){0.f, 0.f, 0.f, 0.f};
    bf16x8 At[4][2], B0[2][2], B1[2][2];
    const char* cA = (const char*)g.A + (size_t)cur.pm * tstep; const char* cB = (const char*)g.Bt + (size_t)cur.pn * tstep;
    S.a_ready(cur);
    if constexpr (SP2) {
        PG8_STAGE(PG8_SB(0, 0), cB, voffB); PG8_STAGE(PG8_SB(0, 1), cB + hstep, voffB); PG8_STAGE(PG8_SA(0, 0), cA, voffA); PG8_STAGE(PG8_SA(0, 1), cA + hstep, voffA);
        if (wr == 1) PG8_BAR;
        PG8_WAIT_V(2); PG8_BAR;
        PG8_STAGE(PG8_SB(1, 0), cB + kstep, voffB); PG8_STAGE(PG8_SA(1, 0), cA + kstep, voffA); PG8_STAGE(PG8_SB(1, 1), cB + hstep + kstep, voffB);
        PG8_WAIT_V(6); PG8_BAR;
    } else {
        PG8_STAGE(PG8_SB(0, 0), cB, voffB); PG8_STAGE(PG8_SA(0, 0), cA, voffA); PG8_STAGE(PG8_SB(0, 1), cB + hstep, voffB); PG8_STAGE(PG8_SA(0, 1), cA + hstep, voffA);
        if (wr == 1) PG8_BAR;
        PG8_WAIT_V(4); PG8_BAR;
        PG8_STAGE(PG8_SB(1, 0), cB + kstep, voffB); PG8_STAGE(PG8_SA(1, 0), cA + kstep, voffA); PG8_STAGE(PG8_SB(1, 1), cB + hstep + kstep, voffB);
        PG8_WAIT_V(6); PG8_BAR;
    }
    for (;;) {
        const bool has_next = S.next(ui + 1, nxt);
        const char* nA = has_next ? (const char*)g.A + (size_t)nxt.pm * tstep : cA; const char* nB = has_next ? (const char*)g.Bt + (size_t)nxt.pn * tstep : cB;
        for (int t = 0; t < nt; t += 2) {
            const bool last = (t == nt - 2);
            const char* a1 = cA + (size_t)(t + 1) * kstep;
            const char* a2 = last ? nA : cA + (size_t)(t + 2) * kstep; const char* b2 = last ? nB : cB + (size_t)(t + 2) * kstep;
            const char* a3 = a2 + kstep; const char* b3 = b2 + kstep;
            if (last && has_next) S.a_ready(nxt);
            if constexpr (SP2) {
            PG8_LDB(B0, 0, 0); PG8_LDB(B1, 0, 1); PG8_SCHED; PG8_LDA(At, 0, 0); PG8_STAGE(PG8_SA(1, 1), a1 + hstep, voffA);
            PG8_WAIT_V(8); PG8_WAIT_L(0); PG8_BAR; PG8_MMA(0, 0, At, B0); PG8_MMA(0, 1, At, B1); PG8_BAR; PG8_SCHED;
            PG8_LDA(At, 0, 1); PG8_STAGE(PG8_SB(0, 0), b2, voffB); PG8_STAGE(PG8_SB(0, 1), b2 + hstep, voffB); PG8_STAGE(PG8_SA(0, 0), a2, voffA);
            PG8_WAIT_V(8); PG8_WAIT_L(0); PG8_BAR; PG8_MMA(1, 0, At, B0); PG8_MMA(1, 1, At, B1); PG8_BAR; PG8_SCHED;
            PG8_LDB(B0, 1, 0); PG8_LDB(B1, 1, 1); PG8_SCHED; PG8_LDA(At, 1, 0); PG8_STAGE(PG8_SA(0, 1), a2 + hstep, voffA);
            PG8_WAIT_V(8); PG8_WAIT_L(0); PG8_BAR; PG8_MMA(0, 0, At, B0); PG8_MMA(0, 1, At, B1); PG8_BAR; PG8_SCHED;
            PG8_LDA(At, 1, 1); PG8_STAGE(PG8_SB(1, 0), b3, voffB); PG8_STAGE(PG8_SB(1, 1), b3 + hstep, voffB); PG8_STAGE(PG8_SA(1, 0), a3, voffA);
            PG8_WAIT_V(8); PG8_WAIT_L(0); PG8_BAR; PG8_MMA(1, 0, At, B0); PG8_MMA(1, 1, At, B1); PG8_BAR; PG8_SCHED;
            } else {
            PG8_LDB(B0, 0, 0); PG8_SCHED; PG8_LDA(At, 0, 0); PG8_STAGE(PG8_SA(1, 1), a1 + hstep, voffA);
            PG8_WAIT_L(8); PG8_BAR; PG8_WAIT_L(0); PG8_MMA(0, 0, At, B0); PG8_BAR; PG8_SCHED;
            PG8_LDB(B1, 0, 1); PG8_STAGE(PG8_SB(0, 0), b2, voffB);
            PG8_BAR; PG8_WAIT_L(0); PG8_MMA(0, 1, At, B1); PG8_BAR;
            PG8_LDA(At, 0, 1); PG8_STAGE(PG8_SA(0, 0), a2, voffA);
            PG8_BAR; PG8_WAIT_L(0); PG8_MMA(1, 0, At, B0); PG8_BAR; PG8_SCHED;
            PG8_STAGE(PG8_SB(0, 1), b2 + hstep, voffB);
            PG8_WAIT_V(6); PG8_BAR; PG8_MMA(1, 1, At, B1); PG8_BAR;
            PG8_LDB(B0, 1, 0); PG8_SCHED; PG8_LDA(At, 1, 0); PG8_STAGE(PG8_SA(0, 1), a2 + hstep, voffA);
            PG8_WAIT_L(8); PG8_BAR; PG8_WAIT_L(0); PG8_MMA(0, 0, At, B0); PG8_BAR; PG8_SCHED;
            PG8_LDB(B1, 1, 1); PG8_STAGE(PG8_SB(1, 0), b3, voffB);
            PG8_BAR; PG8_WAIT_L(0); PG8_MMA(0, 1, At, B1); PG8_BAR;
            PG8_LDA(At, 1, 1); PG8_STAGE(PG8_SA(1, 0), a3, voffA);
            PG8_BAR; PG8_WAIT_L(0); PG8_MMA(1, 0, At, B0); PG8_BAR; PG8_SCHED;
            PG8_STAGE(PG8_SB(1, 1), b3 + hstep, voffB);
            PG8_WAIT_V(6); PG8_BAR; PG8_MMA(1, 1, At, B1); PG8_BAR;
            }
        }
        if constexpr (ALIGN_EPI) { if (wr == 0) PG8_BAR; }
        if constexpr (!Epi::AFTER_DRAIN) { E(acc, cur, wr, wc, fr, fq); S.done(cur); }
        if (!has_next) break;
#pragma unroll
        for (int a = 0; a < 2; ++a)
#pragma unroll
            for (int b = 0; b < 2; ++b)
#pragma unroll
                for (int m = 0; m < 4; ++m)
#pragma unroll
                    for (int n = 0; n < 2; ++n) acc[a][b][m][n] = (f32x4){0.f, 0.f, 0.f, 0.f};
        cur = nxt; cA = nA; cB = nB; ++ui;
        if constexpr (ALIGN_EPI) { if (wr == 1) PG8_BAR; }
    }
    PG8_WAIT_V(0);
    if constexpr (!ALIGN_EPI) { if (wr == 0) PG8_BAR; }
    PG8_BAR;
    if constexpr (Epi::AFTER_DRAIN) { E.fused(acc, cur, wr, wc, fr, fq, lds, wid, lane); S.done(cur); }
#undef PG8_SA
#undef PG8_SB
#undef PG8_STAGE
#undef PG8_LDA
#undef PG8_LDB
#undef PG8_MMA
#undef PG8_WAIT_V
#undef PG8_WAIT_L
#undef PG8_BAR
#undef PG8_SCHED
}
}
using pg8::bf16_t; using pg8::bf16x8; using pg8::f32x4; using pg8::u32x4; using pg8::u32x2; using pg8::cvt_pk_bf16; using pg8::silu_f; using pg8::RMS_EPS;
#define LAS __attribute__((address_space(3)))
#define LDS_WAIT() asm volatile("s_waitcnt lgkmcnt(0)" ::: "memory")

constexpr int DM = 2048, SEQ = 2048, M = 8192, DFF = 5632, DIN = 4112, DU = 4096;
constexpr int OQ = 1024, OKK = 1536, OV = 2048, OG = 3072;
constexpr int NWAVES = 8, NTHR = 512;
constexpr float INV_DM = 1.0f / 2048.0f;

constexpr size_t MiB = 1u << 20;
constexpr size_t WS_ROWSS = 0;
constexpr size_t WS_GL = 256 * 1024;
constexpr size_t WS_DEC = 1 * MiB;
constexpr size_t WS_W1IN = 2 * MiB, WS_W1OUT = 46 * MiB, WS_WMIX = 68 * MiB, WS_WPOOL = 85 * MiB, WS_WOUT = 86 * MiB, WS_W2IN = 94 * MiB, WS_W2OUT = 138 * MiB;
constexpr size_t WS_A = 160 * MiB, WS_ACT = 192 * MiB, WS_U = 192 * MiB, WS_Y = 256 * MiB, WS_KVT = 2 * MiB  , WS_ST = 288 * MiB  , WS_QD = 320 * MiB  , WS_KI = 328 * MiB, WS_END = 336 * MiB;

constexpr int RING_BYTES = 131072, LDS_BYTES = 147456;

__device__ __forceinline__ unsigned f2bf(float f) { unsigned u = __builtin_bit_cast(unsigned, f); return (u + 0x7fffu + ((u >> 16) & 1u)) >> 16; }
__device__ __forceinline__ unsigned pk2(float lo, float hi) { return f2bf(lo) | (f2bf(hi) << 16); }
__device__ __forceinline__ float bf_lo(unsigned v) { return __builtin_bit_cast(float, v << 16); }
__device__ __forceinline__ float bf_hi(unsigned v) { return __builtin_bit_cast(float, v & 0xffff0000u); }
__device__ __forceinline__ float wave_sum(float v) {
#pragma unroll
    for (int o = 1; o < 64; o <<= 1) v += __shfl_xor(v, o);
    return v;
}
#define MFMA16(a, b, c) __builtin_amdgcn_mfma_f32_16x16x32_bf16((a), (b), (c), 0, 0, 0)

__device__ __forceinline__ int swiglu_row(int n) { return n < DFF ? ((n >> 7) * 256 + (n & 127)) : (((n - DFF) >> 7) * 256 + 128 + ((n - DFF) & 127)); }
__device__ __forceinline__ void transpose_item(const float* W, int K, int N, bf16_t* WT, int mode, LAS float* scr, int item, int lane) {
    const int nblk = (N + 31) / 32, kb = item / nblk, nb = item % nblk, k0 = 64 * kb, n0 = 32 * nb;
    const int rsub = lane >> 3, n4 = (lane & 7) * 4; const bool ok = (n0 + n4) < N;
    f32x4 v[8];
#pragma unroll
    for (int i = 0; i < 8; ++i) v[i] = ok ? *(const f32x4*)(W + (size_t)(k0 + 8 * i + rsub) * N + n0 + n4) : (f32x4){0.f, 0.f, 0.f, 0.f};
#pragma unroll
    for (int i = 0; i < 8; ++i) { LAS float* d = scr + (8 * i + rsub) * 33 + n4; d[0] = v[i][0]; d[1] = v[i][1]; d[2] = v[i][2]; d[3] = v[i][3]; }
    LDS_WAIT();
    const int c = lane & 7;
#pragma unroll
    for (int j = 0; j < 4; ++j) { const int n = (lane >> 3) + 8 * j; const LAS float* s = scr + (8 * c) * 33 + n;
        u32x4 o; o.x = pk2(s[0 * 33], s[1 * 33]); o.y = pk2(s[2 * 33], s[3 * 33]); o.z = pk2(s[4 * 33], s[5 * 33]); o.w = pk2(s[6 * 33], s[7 * 33]);
        const int nn = n0 + n;
        if (nn < N) { const int drow = mode == 1 ? swiglu_row(nn) : nn; *(u32x4*)(WT + (size_t)drow * K + k0 + 8 * c) = o; } }
    LDS_WAIT();
}

struct Args { const float* in[16]; float* out; unsigned char* ws; int ph_lo, ph_hi; };

__device__ __forceinline__ void p0_prologue(const Args& a, LAS unsigned char* lds, int gw, int NGW, int lane, int wave) {
    unsigned char* ws = a.ws;
    LAS float* scr = (LAS float*)(lds + wave * 16384);
    constexpr int I_IN = (DM / 64) * (2 * DFF / 32), I_OUT = (DFF / 64) * (DM / 32), I_MIX = (DM / 64) * ((DIN + 31) / 32), I_POOL1 = (256 / 64) * (256 / 32), I_O = (DM / 64) * (DM / 32);
    constexpr int NITEMS = 2 * I_IN + 2 * I_OUT + I_MIX + 4 * I_POOL1 + I_O;
    for (int it = gw; it < NITEMS; it += NGW) {
        int r = it;
        if (r < I_IN) { transpose_item(a.in[2], DM, 2 * DFF, (bf16_t*)(ws + WS_W1IN), 1, scr, r, lane); continue; } r -= I_IN;
        if (r < I_OUT) { transpose_item(a.in[3], DFF, DM, (bf16_t*)(ws + WS_W1OUT), 0, scr, r, lane); continue; } r -= I_OUT;
        if (r < I_MIX) { transpose_item(a.in[5], DM, DIN, (bf16_t*)(ws + WS_WMIX), 0, scr, r, lane); continue; } r -= I_MIX;
        if (r < 4 * I_POOL1) { const int g = r / I_POOL1; transpose_item(a.in[6] + g * 65536, 256, 256, (bf16_t*)(ws + WS_WPOOL) + g * 65536, 0, scr, r % I_POOL1, lane); continue; } r -= 4 * I_POOL1;
        if (r < I_O) { transpose_item(a.in[11], DM, DM, (bf16_t*)(ws + WS_WOUT), 0, scr, r, lane); continue; } r -= I_O;
        if (r < I_IN) { transpose_item(a.in[13], DM, 2 * DFF, (bf16_t*)(ws + WS_W2IN), 1, scr, r, lane); continue; } r -= I_IN;
        transpose_item(a.in[14], DFF, DM, (bf16_t*)(ws + WS_W2OUT), 0, scr, r, lane);
    }
    const float* x = a.in[0]; const float* g1 = a.in[1]; bf16_t* A = (bf16_t*)(ws + WS_A); float* rowss = (float*)(ws + WS_ROWSS);
    for (int m = gw; m < M; m += NGW) {
        const f32x4* xr = (const f32x4*)(x + (size_t)m * DM) + lane; const f32x4* gr = (const f32x4*)g1 + lane;
        u32x2* o = (u32x2*)(A + (size_t)m * DM) + lane; float s = 0.f;
#pragma unroll
        for (int j = 0; j < 8; ++j) { const f32x4 v = xr[64 * j]; const f32x4 g = gr[64 * j]; s += (v[0] * v[0] + v[1] * v[1]) + (v[2] * v[2] + v[3] * v[3]);
            u32x2 w; w.x = cvt_pk_bf16(v[0] * g[0], v[1] * g[1]); w.y = cvt_pk_bf16(v[2] * g[2], v[3] * g[3]); o[64 * j] = w; }
        s = wave_sum(s);
        if (lane == 0) { rowss[m] = s; rowss[M + m] = 0.f; rowss[2 * M + m] = 0.f; rowss[3 * M + m] = 0.f; }
    }
}

__device__ __forceinline__ void gatelr_phase(const bf16_t* A, const bf16_t* WTr, const float* rowss, float* GL, LAS unsigned char* lds, int G, int tid, int wave, int lane) {
    const int fr = lane & 15, fq = lane >> 4, tg = wave >> 2, kq = wave & 3;
    LAS float* P = (LAS float*)lds;
    for (int tb = blockIdx.x; tb < M / 32; tb += G) {
        const int t0 = 32 * tb;
        const bf16_t* ap = A + (size_t)(t0 + 16 * tg + fr) * DM + kq * 512 + 8 * fq;
        const bf16_t* bp = WTr + (size_t)fr * DM + kq * 512 + 8 * fq;
        f32x4 acc = {0.f, 0.f, 0.f, 0.f};
#pragma unroll 8
        for (int ks = 0; ks < 16; ++ks) { const bf16x8 av = *(const bf16x8*)(ap + 32 * ks); const bf16x8 bv = *(const bf16x8*)(bp + 32 * ks); acc = MFMA16(av, bv, acc); }
        *(LAS f32x4*)(P + (wave * 64 + lane) * 4) = acc;
        __syncthreads();
        { const int tok = tid >> 4, r = tid & 15, tg2 = tok >> 4, tl = tok & 15, ln = r + 16 * (tl >> 2), j = tl & 3; float s = 0.f;
#pragma unroll
          for (int q = 0; q < 4; ++q) s += P[((tg2 * 4 + q) * 64 + ln) * 4 + j];
          GL[(size_t)(t0 + tok) * 16 + r] = s * rsqrtf(rowss[t0 + tok] * INV_DM + RMS_EPS); }
        __syncthreads();
    }
}

__device__ __forceinline__ void pool_task(int task, const bf16_t* U, const bf16_t* WpT, const float* pool_scale, bf16_t* Y, LAS unsigned char* lds, int tid, int wave, int lane) {
    const int tt = task >> 2, g = task & 3, T0 = 64 * tt, p0 = T0 % SEQ, w = 2 << g;
    const int fr = lane & 15, fq = lane >> 4;
    LAS bf16_t* UL = (LAS bf16_t*)lds;
    LAS bf16_t* PA = (LAS bf16_t*)(lds + 40960);
#pragma unroll
    for (int i = 0; i < 5; ++i) { const int ch = tid + 512 * i, r = ch >> 5, c16 = ch & 31, pos = p0 - 16 + r;
        u32x4 v = {0u, 0u, 0u, 0u};
        if (pos >= 0) v = *(const u32x4*)(U + (size_t)(T0 - 16 + r) * DU + g * 256 + c16 * 8);
        *(LAS u32x4*)(UL + r * 256 + c16 * 8) = v; }
    __syncthreads();
    {
        const int cp = tid & 127, tq = tid >> 7, i0 = 16 * tq;
        const LAS unsigned* UL32 = (const LAS unsigned*)UL; LAS unsigned* PA32 = (LAS unsigned*)PA;
        float s0 = 0.f, s1 = 0.f;
        for (int s = i0 - w + 1; s < i0; ++s) { const unsigned v = UL32[(s + 16) * 128 + cp]; s0 += bf_lo(v); s1 += bf_hi(v); }
        for (int i = i0; i < i0 + 16; ++i) {
            const unsigned v = UL32[(i + 16) * 128 + cp]; const float a0 = bf_lo(v), a1 = bf_hi(v);
            s0 += a0; s1 += a1;
            const int pos = p0 + i; const int cnt = (pos + 1) < w ? (pos + 1) : w; const float inv = 1.0f / (float)cnt;
            PA32[i * 132 + cp] = cvt_pk_bf16(s0 * inv - a0, s1 * inv - a1);
            const unsigned o = UL32[(i - w + 1 + 16) * 128 + cp]; s0 -= bf_lo(o); s1 -= bf_hi(o);
        }
    }
    __syncthreads();
    f32x4 acc[4][2];
#pragma unroll
    for (int mt = 0; mt < 4; ++mt)
#pragma unroll
        for (int nt = 0; nt < 2; ++nt) acc[mt][nt] = (f32x4){0.f, 0.f, 0.f, 0.f};
    const bf16_t* wp = WpT + (size_t)g * 65536 + (size_t)(32 * wave + fr) * 256 + 8 * fq;
#pragma unroll
    for (int ks = 0; ks < 8; ++ks) {
        bf16x8 wf[2];
#pragma unroll
        for (int nt = 0; nt < 2; ++nt) wf[nt] = *(const bf16x8*)(wp + nt * 16 * 256 + 32 * ks);
#pragma unroll
        for (int mt = 0; mt < 4; ++mt) { const bf16x8 af = *(const LAS bf16x8*)(PA + (16 * mt + fr) * 264 + 32 * ks + 8 * fq);
#pragma unroll
            for (int nt = 0; nt < 2; ++nt) acc[mt][nt] = MFMA16(wf[nt], af, acc[mt][nt]); }
    }
#pragma unroll
    for (int nt = 0; nt < 2; ++nt) { const int n = 32 * wave + 16 * nt + 4 * fq; const f32x4 sc = *(const f32x4*)(pool_scale + g * 256 + n);
#pragma unroll
        for (int mt = 0; mt < 4; ++mt) { const f32x4 v = acc[mt][nt] * sc; u32x2 o; o.x = cvt_pk_bf16(v[0], v[1]); o.y = cvt_pk_bf16(v[2], v[3]);
            *(u32x2*)(Y + (size_t)(T0 + 16 * mt + fr) * DM + g * 256 + n) = o; } }
    __syncthreads();
}

#ifndef B_FAST
#define B_FAST 1
#endif
#ifndef B_QK
#define B_QK 1
#endif
#ifndef B_BF16
#define B_BF16 1
#endif
#if B_FAST
__device__ __forceinline__ float fexp(float x) { return __builtin_amdgcn_exp2f(x * 1.44269504089f); }
__device__ __forceinline__ float flog1pexp(float na) { return __builtin_amdgcn_logf(1.0f + fexp(na)) * 0.69314718056f; }
#else
__device__ __forceinline__ float fexp(float x) { return expf(x); }
__device__ __forceinline__ float flog1pexp(float na) { return log1pf(expf(na)); }
#endif
#if B_BF16
typedef bf16_t kv_t;
#else
typedef float kv_t;
#endif
__device__ __forceinline__ void gla_bcum(const float* GL, const float* w_alpha, const float* b_alpha, int T0, int h, LAS float* GLs, LAS float* BC, LAS float* SEG, int tid) {
    for (int i = tid; i < 1024; i += NTHR) GLs[i] = GL[(size_t)T0 * 16 + i];
    const int d = tid & 127, q = tid >> 7;
    float wa[16];
#pragma unroll
    for (int r = 0; r < 16; ++r) wa[r] = w_alpha[r * 512 + h * 128 + d];
    const float ba = b_alpha[h * 128 + d];
    __syncthreads();
    float c = 0.f;
#pragma unroll 4
    for (int tt = 0; tt < 16; ++tt) { const int t = 16 * q + tt; float z = ba;
#pragma unroll
        for (int r = 0; r < 16; ++r) z += GLs[t * 16 + r] * wa[r];
        const float ls = fminf(z, 0.f) - flog1pexp(-fabsf(z));
        c += ls * 0.0625f; BC[t * 128 + d] = c; }
    SEG[q * 128 + d] = c;
    __syncthreads();
    float off = 0.f;
    for (int qq = 0; qq < q; ++qq) off += SEG[qq * 128 + d];
    if (q > 0) {
#pragma unroll 4
        for (int tt = 0; tt < 16; ++tt) BC[(16 * q + tt) * 128 + d] += off; }
    __syncthreads();
}
__device__ __forceinline__ u32x4 pack8(const unsigned (&b)[8]) { u32x4 o; o.x = b[0] | (b[1] << 16); o.y = b[2] | (b[3] << 16); o.z = b[4] | (b[5] << 16); o.w = b[6] | (b[7] << 16); return o; }
__device__ __forceinline__ void gla_stage_vt(const bf16_t* U, int T0, int h, LAS bf16_t* VT, int tid) {
    const int dvp = tid & 127, cgrp = tid >> 7;
#pragma unroll
    for (int hf = 0; hf < 2; ++hf) { const int c8 = 16 * cgrp + 8 * hf; unsigned a[8], b[8];
#pragma unroll
        for (int cc = 0; cc < 8; ++cc) { const unsigned vv = *(const unsigned*)(U + (size_t)(T0 + c8 + cc) * DU + OV + h * 256 + 2 * dvp); a[cc] = vv & 0xffffu; b[cc] = vv >> 16; }
        *(LAS u32x4*)(VT + (2 * dvp) * 72 + c8) = pack8(a); *(LAS u32x4*)(VT + (2 * dvp + 1) * 72 + c8) = pack8(b); }
}
constexpr int GL_OFF = 0, BC_OFF = 4096, SEG_OFF = 36864;
__device__ __forceinline__ void gla_kv_task(int task, const bf16_t* U, const float* GL, const float* w_alpha, const float* b_alpha, kv_t* KVT, float* DEC, bf16_t* QDg, bf16_t* KIg, LAS unsigned char* lds, int tid, int wave, int lane) {
    const int b = task >> 7, h = (task >> 5) & 3, n = task & 31, T0 = b * SEQ + n * 64;
    const int fr = lane & 15, fq = lane >> 4;
    LAS float* GLs = (LAS float*)(lds + GL_OFF); LAS float* BC = (LAS float*)(lds + BC_OFF); LAS float* SEG = (LAS float*)(lds + SEG_OFF);
    LAS bf16_t* KT = (LAS bf16_t*)(lds + 38912);
    LAS bf16_t* VT = (LAS bf16_t*)(lds + 57344);
    gla_bcum(GL, w_alpha, b_alpha, T0, h, GLs, BC, SEG, tid);
    { const int dp = tid & 63, cg8 = tid >> 6; const float bl0 = BC[63 * 128 + 2 * dp], bl1 = BC[63 * 128 + 2 * dp + 1]; unsigned k0[8], k1[8];
#pragma unroll
      for (int cc = 0; cc < 8; ++cc) { const int c = 8 * cg8 + cc; const bf16_t* up = U + (size_t)(T0 + c) * DU + h * 128 + 2 * dp;
          const unsigned k2 = *(const unsigned*)(up + OKK); const float b0 = BC[c * 128 + 2 * dp], b1 = BC[c * 128 + 2 * dp + 1];
          const float kl = bf_lo(k2), kh = bf_hi(k2);
          k0[cc] = f2bf(kl * fexp(bl0 - b0)); k1[cc] = f2bf(kh * fexp(bl1 - b1));
#if B_QK
          const unsigned q2 = *(const unsigned*)(up + OQ); const float qs = 0.08838834764831845f;
          *(unsigned*)(QDg + (size_t)(T0 + c) * 512 + h * 128 + 2 * dp) = cvt_pk_bf16(bf_lo(q2) * qs * fexp(b0), bf_hi(q2) * qs * fexp(b1));
          *(unsigned*)(KIg + (size_t)(T0 + c) * 512 + h * 128 + 2 * dp) = cvt_pk_bf16(kl * fexp(-b0), kh * fexp(-b1));
#endif
      }
      const int dk = 2 * dp;
#if B_BF16
      const int slot = (dk & ~31) | (((dk >> 2) & 1) << 4) | (((dk >> 3) & 3) << 2) | (dk & 3);
#else
      const int slot = dk;
#endif
      *(LAS u32x4*)(KT + slot * 72 + 8 * cg8) = pack8(k0); *(LAS u32x4*)(KT + (slot + 1) * 72 + 8 * cg8) = pack8(k1); }
    gla_stage_vt(U, T0, h, VT, tid);
    __syncthreads();
    f32x4 acc[2][8];
#pragma unroll
    for (int mt = 0; mt < 2; ++mt)
#pragma unroll
        for (int nt = 0; nt < 8; ++nt) acc[mt][nt] = (f32x4){0.f, 0.f, 0.f, 0.f};
#pragma unroll
    for (int ks = 0; ks < 2; ++ks) { bf16x8 vf[2];
#pragma unroll
        for (int mt = 0; mt < 2; ++mt) vf[mt] = *(const LAS bf16x8*)(VT + (32 * wave + 16 * mt + fr) * 72 + 32 * ks + 8 * fq);
#pragma unroll
        for (int nt = 0; nt < 8; ++nt) { const bf16x8 kf = *(const LAS bf16x8*)(KT + (16 * nt + fr) * 72 + 32 * ks + 8 * fq);
#pragma unroll
            for (int mt = 0; mt < 2; ++mt) acc[mt][nt] = MFMA16(kf, vf[mt], acc[mt][nt]); } }
    kv_t* kvp = KVT + (size_t)task * 32768;
#if B_BF16
#pragma unroll
    for (int mt = 0; mt < 2; ++mt)
#pragma unroll
        for (int p = 0; p < 4; ++p) { const f32x4 v0 = acc[mt][2 * p], v1 = acc[mt][2 * p + 1];
            u32x4 w; w.x = cvt_pk_bf16(v0[0], v0[1]); w.y = cvt_pk_bf16(v0[2], v0[3]); w.z = cvt_pk_bf16(v1[0], v1[1]); w.w = cvt_pk_bf16(v1[2], v1[3]);
            *(u32x4*)(kvp + (32 * wave + 16 * mt + fr) * 128 + 32 * p + 8 * fq) = w; }
#else
#pragma unroll
    for (int mt = 0; mt < 2; ++mt)
#pragma unroll
        for (int nt = 0; nt < 8; ++nt) *(f32x4*)(kvp + (32 * wave + 16 * mt + fr) * 128 + 16 * nt + 4 * fq) = acc[mt][nt];
#endif
    if (tid < 128) DEC[task * 128 + tid] = fexp(BC[63 * 128 + tid]);
    __syncthreads();
}
__device__ __forceinline__ void gla_scan_phase(const kv_t* KVT, kv_t* ST, const float* DEC, int G, int tid) {
    for (int e = blockIdx.x * NTHR + tid; e < 16 * 8192; e += G * NTHR) {
        const int bh = e >> 13, e4 = e & 8191, dk0 = (e4 * 4) & 127;
        f32x4 st = {0.f, 0.f, 0.f, 0.f};
#if B_BF16
        for (int n0 = 0; n0 < 32; n0 += 16) { u32x2 kv[16]; f32x4 dc[16];
#pragma unroll
            for (int j = 0; j < 16; ++j) { kv[j] = *(const u32x2*)(KVT + (size_t)(bh * 32 + n0 + j) * 32768 + e4 * 4); dc[j] = *(const f32x4*)(DEC + (bh * 32 + n0 + j) * 128 + dk0); }
#pragma unroll
            for (int j = 0; j < 16; ++j) { u32x2 o; o.x = cvt_pk_bf16(st[0], st[1]); o.y = cvt_pk_bf16(st[2], st[3]);
                *(u32x2*)(ST + (size_t)(bh * 32 + n0 + j) * 32768 + e4 * 4) = o;
                const f32x4 k = {bf_lo(kv[j].x), bf_hi(kv[j].x), bf_lo(kv[j].y), bf_hi(kv[j].y)}; st = st * dc[j] + k; } }
#else
        for (int n0 = 0; n0 < 32; n0 += 8) { f32x4 kv[8], dc[8];
#pragma unroll
            for (int j = 0; j < 8; ++j) { kv[j] = *(const f32x4*)(KVT + (size_t)(bh * 32 + n0 + j) * 32768 + e4 * 4); dc[j] = *(const f32x4*)(DEC + (bh * 32 + n0 + j) * 128 + dk0); }
#pragma unroll
            for (int j = 0; j < 8; ++j) { *(f32x4*)(ST + (size_t)(bh * 32 + n0 + j) * 32768 + e4 * 4) = st; st = st * dc[j] + kv[j]; } }
#endif
    }
}
__device__ __forceinline__ void gla_out_task(int task, const bf16_t* U, const float* GL, const float* w_alpha, const float* b_alpha, const bf16_t* QDg, const bf16_t* KIg, const kv_t* STg, const float* gla_norm, bf16_t* Y, LAS unsigned char* lds, int tid, int wave, int lane) {
    const int b = task >> 7, h = (task >> 5) & 3, n = task & 31, T0 = b * SEQ + n * 64;
    const int fr = lane & 15, fq = lane >> 4;
    LAS bf16_t* QD = (LAS bf16_t*)(lds + 38912);
    LAS bf16_t* KI = (LAS bf16_t*)(lds + 56320);
    LAS bf16_t* SC = (LAS bf16_t*)(lds + 73728);
    LAS bf16_t* VT = (LAS bf16_t*)(lds + 82944);
    LAS float* RS = (LAS float*)(lds + 119808);
    const kv_t* stp = STg + (size_t)task * 32768;
#ifndef B_LATE
#define B_LATE 0
#endif
#if B_BF16 && !B_LATE
    bf16x8 stf[4][2];
#pragma unroll
    for (int ks = 0; ks < 4; ++ks)
#pragma unroll
        for (int nt = 0; nt < 2; ++nt) stf[ks][nt] = *(const bf16x8*)(stp + (32 * wave + 16 * nt + fr) * 128 + 32 * ks + 8 * fq);
#endif
#if B_QK
#pragma unroll
    for (int i = 0; i < 2; ++i) { const int ch = tid + 512 * i, r = ch >> 4, c16 = ch & 15;
        *(LAS u32x4*)(QD + r * 136 + c16 * 8) = *(const u32x4*)(QDg + (size_t)(T0 + r) * 512 + h * 128 + c16 * 8);
        *(LAS u32x4*)(KI + r * 136 + c16 * 8) = *(const u32x4*)(KIg + (size_t)(T0 + r) * 512 + h * 128 + c16 * 8); }
#else
    { LAS float* GLs = (LAS float*)(lds + GL_OFF); LAS float* BC = (LAS float*)(lds + BC_OFF); LAS float* SEG = (LAS float*)(lds + SEG_OFF);
      gla_bcum(GL, w_alpha, b_alpha, T0, h, GLs, BC, SEG, tid);
      const int dp = tid & 63, cg8 = tid >> 6; LAS unsigned* QD32 = (LAS unsigned*)QD; LAS unsigned* KI32 = (LAS unsigned*)KI; const float qs = 0.08838834764831845f;
#pragma unroll
      for (int cc = 0; cc < 8; ++cc) { const int c = 8 * cg8 + cc; const bf16_t* up = U + (size_t)(T0 + c) * DU + h * 128 + 2 * dp;
          const unsigned q2 = *(const unsigned*)(up + OQ), k2 = *(const unsigned*)(up + OKK); const float b0 = BC[c * 128 + 2 * dp], b1 = BC[c * 128 + 2 * dp + 1];
          QD32[c * 68 + dp] = cvt_pk_bf16(bf_lo(q2) * qs * fexp(b0), bf_hi(q2) * qs * fexp(b1));
          KI32[c * 68 + dp] = cvt_pk_bf16(bf_lo(k2) * fexp(-b0), bf_hi(k2) * fexp(-b1)); } }
#endif
    gla_stage_vt(U, T0, h, VT, tid);
    __syncthreads();
    { const int it = wave & 3, jp = wave >> 2;
#pragma unroll
      for (int jj = 0; jj < 2; ++jj) { const int jt = 2 * jp + jj; f32x4 s = {0.f, 0.f, 0.f, 0.f};
          if (jt <= it) {
#pragma unroll
              for (int ks = 0; ks < 4; ++ks) { const bf16x8 kf = *(const LAS bf16x8*)(KI + (16 * jt + fr) * 136 + 32 * ks + 8 * fq); const bf16x8 qf = *(const LAS bf16x8*)(QD + (16 * it + fr) * 136 + 32 * ks + 8 * fq);
                  s = MFMA16(kf, qf, s); } }
          const int i = 16 * it + fr, j0 = 16 * jt + 4 * fq;
          u32x2 o; o.x = cvt_pk_bf16(j0 + 0 <= i ? s[0] : 0.f, j0 + 1 <= i ? s[1] : 0.f); o.y = cvt_pk_bf16(j0 + 2 <= i ? s[2] : 0.f, j0 + 3 <= i ? s[3] : 0.f);
          *(LAS u32x2*)(SC + i * 72 + j0) = o; } }
    __syncthreads();
    f32x4 acc[4][2];
#pragma unroll
    for (int mt = 0; mt < 4; ++mt)
#pragma unroll
        for (int nt = 0; nt < 2; ++nt) acc[mt][nt] = (f32x4){0.f, 0.f, 0.f, 0.f};
#pragma unroll
    for (int ks = 0; ks < 2; ++ks) { bf16x8 vf[2];
#pragma unroll
        for (int nt = 0; nt < 2; ++nt) vf[nt] = *(const LAS bf16x8*)(VT + (32 * wave + 16 * nt + fr) * 72 + 32 * ks + 8 * fq);
#pragma unroll
        for (int mt = 0; mt < 4; ++mt) { const bf16x8 sf = *(const LAS bf16x8*)(SC + (16 * mt + fr) * 72 + 32 * ks + 8 * fq);
#pragma unroll
            for (int nt = 0; nt < 2; ++nt) acc[mt][nt] = MFMA16(vf[nt], sf, acc[mt][nt]); } }
#pragma unroll
    for (int ks = 0; ks < 4; ++ks) { bf16x8 sf[2];
#pragma unroll
        for (int nt = 0; nt < 2; ++nt) {
#if B_BF16 && !B_LATE
            sf[nt] = stf[ks][nt];
#elif B_BF16
            sf[nt] = *(const bf16x8*)(stp + (32 * wave + 16 * nt + fr) * 128 + 32 * ks + 8 * fq);
#else
            const float* p = stp + (32 * wave + 16 * nt + fr) * 128 + 32 * ks + 8 * fq; const f32x4 lo = *(const f32x4*)p, hi = *(const f32x4*)(p + 4);
            u32x4 w; w.x = cvt_pk_bf16(lo[0], lo[1]); w.y = cvt_pk_bf16(lo[2], lo[3]); w.z = cvt_pk_bf16(hi[0], hi[1]); w.w = cvt_pk_bf16(hi[2], hi[3]); sf[nt] = __builtin_bit_cast(bf16x8, w);
#endif
        }
#pragma unroll
        for (int mt = 0; mt < 4; ++mt) { const bf16x8 qf = *(const LAS bf16x8*)(QD + (16 * mt + fr) * 136 + 32 * ks + 8 * fq);
#pragma unroll
            for (int nt = 0; nt < 2; ++nt) acc[mt][nt] = MFMA16(sf[nt], qf, acc[mt][nt]); } }
#pragma unroll
    for (int mt = 0; mt < 4; ++mt) { float s = 0.f;
#pragma unroll
        for (int nt = 0; nt < 2; ++nt) { const f32x4 v = acc[mt][nt]; s += (v[0] * v[0] + v[1] * v[1]) + (v[2] * v[2] + v[3] * v[3]); }
        s += __shfl_xor(s, 16); s += __shfl_xor(s, 32);
        if (fq == 0) RS[wave * 64 + 16 * mt + fr] = s; }
    __syncthreads();
#pragma unroll
    for (int mt = 0; mt < 4; ++mt) { float tot = 0.f;
#pragma unroll
        for (int w8 = 0; w8 < 8; ++w8) tot += RS[w8 * 64 + 16 * mt + fr];
        const float rstd = rsqrtf(tot * (1.0f / 256.0f) + RMS_EPS); const int tok = T0 + 16 * mt + fr;
#pragma unroll
        for (int nt = 0; nt < 2; ++nt) { const int dv = 32 * wave + 16 * nt + 4 * fq; const f32x4 gn = *(const f32x4*)(gla_norm + dv);
            const u32x2 g2 = *(const u32x2*)(U + (size_t)tok * DU + OG + h * 256 + dv); const f32x4 v = acc[mt][nt] * rstd * gn;
            u32x2 o; o.x = cvt_pk_bf16(v[0] * silu_f(bf_lo(g2.x)), v[1] * silu_f(bf_hi(g2.x))); o.y = cvt_pk_bf16(v[2] * silu_f(bf_lo(g2.y)), v[3] * silu_f(bf_hi(g2.y)));
            *(u32x2*)(Y + (size_t)tok * DM + 1024 + h * 256 + dv) = o; } }
    __syncthreads();
}

#define GAS __attribute__((address_space(1)))
#define XB_TMO      128
#define XB_XCNT(j)  (256  + 64 * (j))
#define XB_XSUB(j)  (1280 + 64 * (j))
#define XB_XGEN(j)  (2304 + 64 * (j))
#define XB_TOP      3328
#define XB_TOPGEN   3392
#define XCD_BAR_WORDS 3456
#define XB_SPIN_CAP (1u << 18)

__device__ __forceinline__ unsigned xb_ld(unsigned* p)              { return __hip_atomic_load(p, __ATOMIC_RELAXED, __HIP_MEMORY_SCOPE_AGENT); }
__device__ __forceinline__ unsigned xb_add(unsigned* p, unsigned v) { return __hip_atomic_fetch_add(p, v, __ATOMIC_RELAXED, __HIP_MEMORY_SCOPE_AGENT); }
__device__ __forceinline__ unsigned xb_xcc_id() { return (unsigned)__builtin_amdgcn_s_getreg((3 << 11) | 20) & 0xFu; }
#define XB_SPIN(cond, bar) do { unsigned _sp = 0; while (cond) { __builtin_amdgcn_s_sleep(1); \
    if ((++_sp & 255u) == 0u) { if (xb_ld(&(bar)[XB_TMO])) break; if (_sp > XB_SPIN_CAP) { atomicAdd(&(bar)[XB_TMO], 1u); break; } } } } while (0)

struct XcdBarrier {
    unsigned* bar; unsigned x;
    volatile LAS unsigned* st;
};

__device__ __forceinline__ XcdBarrier xcd_barrier_post(unsigned* bar, volatile LAS unsigned* st) {
    XcdBarrier b; b.bar = bar; b.x = xb_xcc_id(); b.st = st;
    if (threadIdx.x == 0) (void)xb_add(&bar[XB_XCNT(b.x)], 1u);
    return b;
}
__device__ __forceinline__ void xcd_barrier_complete(unsigned* bar, unsigned x, unsigned& nloc, unsigned& nx) {
    const unsigned G = gridDim.x * gridDim.y * gridDim.z;
    unsigned sum, cnt, mine, sp = 0u;
    for (;;) {
        sum = 0u; cnt = 0u; mine = 0u;
#pragma unroll
        for (unsigned j = 0; j < 16; ++j) { const unsigned c = xb_ld(&bar[XB_XCNT(j)]); sum += c; cnt += (c > 0u) ? 1u : 0u; mine = (j == x) ? c : mine; }
        if (sum == G) break;
        __builtin_amdgcn_s_sleep(1);
        if ((++sp & 255u) == 0u) { if (xb_ld(&bar[XB_TMO])) break; if (sp > XB_SPIN_CAP) { atomicAdd(&bar[XB_TMO], 1u); break; } }
    }
    nloc = mine > 0u ? mine : 1u; nx = cnt > 0u ? cnt : 1u;
}

__device__ __forceinline__ void xcd_barrier(const XcdBarrier& b) {
    asm volatile("s_waitcnt vmcnt(0)" ::: "memory");
    __syncthreads();
    if (threadIdx.x == 0) {
        unsigned* bar = b.bar;
        __builtin_amdgcn_s_waitcnt(0);
        unsigned nloc = b.st[0], nx = b.st[1];
        if (nloc == 0u) { xcd_barrier_complete(bar, b.x, nloc, nx); b.st[0] = nloc; b.st[1] = nx; }
        const unsigned old = xb_add(&bar[XB_XSUB(b.x)], 1u);
        const unsigned gen = old / nloc;
        if (old + 1u == (gen + 1u) * nloc) {
            __builtin_amdgcn_fence(__ATOMIC_RELEASE, "agent");
            asm volatile("s_waitcnt vmcnt(0)" ::: "memory");
            const unsigned og = xb_add(&bar[XB_TOP], 1u);
            const unsigned tg = og / nx;
            if (og + 1u == (tg + 1u) * nx) xb_add(&bar[XB_TOPGEN], 1u);
            else XB_SPIN(xb_ld(&bar[XB_TOPGEN]) == tg, bar);
            __builtin_amdgcn_fence(__ATOMIC_ACQUIRE, "agent");
            xb_add(&bar[XB_XGEN(b.x)], 1u);
            asm volatile("s_waitcnt vmcnt(0)" ::: "memory");
        } else {
            XB_SPIN(xb_ld(&bar[XB_XGEN(b.x)]) == gen, bar);
            __builtin_amdgcn_fence(__ATOMIC_ACQUIRE, "agent");
            asm volatile("s_waitcnt vmcnt(0)" ::: "memory");
        }
    }
    __syncthreads();
}

constexpr size_t WS_BAR = 1 * MiB + 512 * 1024;
__global__ void __launch_bounds__(NTHR, 2) mk_fwd(Args args) {
    extern __shared__ __attribute__((aligned(16))) unsigned char lds_raw[];
    LAS unsigned char* lds = (LAS unsigned char*)lds_raw;
    cg::grid_group grid = cg::this_grid();
    const int tid = threadIdx.x, lane = tid & 63, wave = __builtin_amdgcn_readfirstlane(tid >> 6);
    const int G = gridDim.x, bx = blockIdx.x;
    const int vcu = (G % 8 == 0) ? (bx % 8) * (G / 8) + bx / 8 : bx;
    const int gw = vcu * NWAVES + wave, NGW = G * NWAVES;
    unsigned char* ws = args.ws;
    float* rowss = (float*)(ws + WS_ROWSS); float* GL = (float*)(ws + WS_GL); float* DEC = (float*)(ws + WS_DEC);
    bf16_t* A = (bf16_t*)(ws + WS_A); bf16_t* ACT = (bf16_t*)(ws + WS_ACT); bf16_t* U = (bf16_t*)(ws + WS_U); bf16_t* Y = (bf16_t*)(ws + WS_Y); kv_t* KVT = (kv_t*)(ws + WS_KVT); kv_t* ST = B_BF16 ? (kv_t*)(ws + WS_ST) : KVT; bf16_t* QDg = (bf16_t*)(ws + WS_QD); bf16_t* KIg = (bf16_t*)(ws + WS_KI);
    const int lo = args.ph_lo, hi = args.ph_hi;
    if (tid < 2) ((volatile LAS unsigned*)(lds + RING_BYTES))[tid] = 0u;
    __syncthreads();
    const XcdBarrier bar = xcd_barrier_post((unsigned*)(ws + WS_BAR), (volatile LAS unsigned*)(lds + RING_BYTES));
    if (hi > 1000) grid.sync();
#define IN(k) (lo <= (k) && (k) < hi)
#define SEAM(k) do { if (IN(k) && IN((k) + 1)) xcd_barrier(bar); } while (0)

    if (IN(0)) { p0_prologue(args, lds, gw, NGW, lane, wave); }
    SEAM(0);
    if (IN(1)) { pg8::Gemm g{A, (const bf16_t*)(ws + WS_W1IN), M, 2 * DFF, DM}; pg8::StaticOrder S; S.init(M, 2 * DFF, G, bx);
        pg8::EpiSwiGLU E{ACT, DFF, rowss, INV_DM};
        pg8::gemm_phase<pg8::EpiSwiGLU, pg8::StaticOrder, true, true>(lds, g, S, E); }
    SEAM(1);
    if (IN(2)) { pg8::Gemm g{ACT, (const bf16_t*)(ws + WS_W1OUT), M, DM, DFF}; pg8::StaticOrder S; S.init(M, DM, G, bx);
        pg8::EpiResid E{args.in[0], args.out, 0.5f, A, args.in[4], rowss + M};
        pg8::gemm_phase<pg8::EpiResid, pg8::StaticOrder, true, true>(lds, g, S, E); }
    SEAM(2);
    if (IN(3)) { gatelr_phase(A, (const bf16_t*)(ws + WS_WMIX) + (size_t)DU * DM, rowss + M, GL, lds, G, tid, wave, lane);
        pg8::Gemm g{A, (const bf16_t*)(ws + WS_WMIX), M, DU, DM}; pg8::StaticOrder S; S.init(M, DU, G, bx);
        pg8::EpiScaleBf16 E{U, DU, rowss + M, INV_DM};
        pg8::gemm_phase<pg8::EpiScaleBf16, pg8::StaticOrder, true, true>(lds, g, S, E); }
    SEAM(3);
    if (IN(4)) { for (int t = bx; t < 1024; t += G) {
            if (t < 512) gla_kv_task(t, U, GL, args.in[8], args.in[9], KVT, DEC, QDg, KIg, lds, tid, wave, lane);
            else pool_task(t - 512, U, (const bf16_t*)(ws + WS_WPOOL), args.in[7], Y, lds, tid, wave, lane); } }
    SEAM(4);
    if (IN(5)) { gla_scan_phase(KVT, ST, DEC, G, tid); }
    SEAM(5);
    if (IN(6)) { for (int t = bx; t < 512; t += G) gla_out_task(t, U, GL, args.in[8], args.in[9], QDg, KIg, ST, args.in[10], Y, lds, tid, wave, lane); }
    SEAM(6);
    if (IN(7)) { pg8::Gemm g{Y, (const bf16_t*)(ws + WS_WOUT), M, DM, DM}; pg8::StaticOrder S; S.init(M, DM, G, bx);
        pg8::EpiResid E{args.out, args.out, 1.0f, A, args.in[12], rowss + 2 * M};
        pg8::gemm_phase<pg8::EpiResid, pg8::StaticOrder, true, true>(lds, g, S, E); }
    SEAM(7);
    if (IN(8)) { pg8::Gemm g{A, (const bf16_t*)(ws + WS_W2IN), M, 2 * DFF, DM}; pg8::StaticOrder S; S.init(M, 2 * DFF, G, bx);
        pg8::EpiSwiGLU E{ACT, DFF, rowss + 2 * M, INV_DM};
        pg8::gemm_phase<pg8::EpiSwiGLU, pg8::StaticOrder, true, true>(lds, g, S, E); }
    SEAM(8);
    if (IN(9)) { pg8::Gemm g{ACT, (const bf16_t*)(ws + WS_W2OUT), M, DM, DFF}; pg8::StaticOrder S; S.init(M, DM, G, bx);
        pg8::EpiResid E{args.out, args.out, 0.5f, nullptr, nullptr, rowss + 3 * M};
        pg8::gemm_phase<pg8::EpiResid, pg8::StaticOrder, true, true>(lds, g, S, E); }
    SEAM(9);
    if (IN(10)) { const float* fn = args.in[15];
        for (int m = gw; m < M; m += NGW) { f32x4* orow = (f32x4*)(args.out + (size_t)m * DM) + lane; const f32x4* gr = (const f32x4*)fn + lane;
            const float rs = rsqrtf(rowss[3 * M + m] * INV_DM + RMS_EPS);
#pragma unroll
            for (int j = 0; j < 8; ++j) { const f32x4 v = orow[64 * j]; orow[64 * j] = v * rs * gr[64 * j]; } } }
#undef IN
#undef SEAM
}

#ifndef MK_N_LAUNCHES
#define MK_N_LAUNCHES 1
#endif
extern "C" void kernel_launch(void* const* d_in, const int* in_sizes, int n_in, void* d_out, int out_size, void* d_ws, size_t ws_size, hipStream_t stream) {
    static int grid = 0;
    if (grid == 0) {
        if (n_in != 16 || out_size != M * DM || ws_size < WS_END) { fprintf(stderr, "kernel_launch: unexpected shapes (n_in %d out %d ws %zu)\n", n_in, out_size, ws_size); grid = -1; return; }
        int dev = 0, cus = 0, per_cu = 0;
        if (hipGetDevice(&dev) != hipSuccess || hipDeviceGetAttribute(&cus, hipDeviceAttributeMultiprocessorCount, dev) != hipSuccess) { grid = -1; return; }
        if (hipFuncSetAttribute((const void*)mk_fwd, hipFuncAttributeMaxDynamicSharedMemorySize, LDS_BYTES) != hipSuccess) { fprintf(stderr, "kernel_launch: hipFuncSetAttribute failed\n"); grid = -1; return; }
        if (hipOccupancyMaxActiveBlocksPerMultiprocessor(&per_cu, (const void*)mk_fwd, NTHR, LDS_BYTES) != hipSuccess || per_cu < 1) { fprintf(stderr, "kernel_launch: occupancy query says %d\n", per_cu); per_cu = 1; }
        (void)hipGetLastError();
        grid = cus;
    }
    if (grid < 0) return;
    if (hipMemsetAsync((char*)d_ws + WS_BAR, 0, XCD_BAR_WORDS * 4, stream) != hipSuccess) { fprintf(stderr, "kernel_launch: memset failed\n"); return; }
    Args a{};
    for (int i = 0; i < 16; ++i) a.in[i] = (const float*)d_in[i];
    a.out = (float*)d_out; a.ws = (unsigned char*)d_ws;
#if MK_N_LAUNCHES == 1
    a.ph_lo = 0; a.ph_hi = 11;
    void* kargs[] = {&a};
    hipError_t e = hipLaunchCooperativeKernel((const void*)mk_fwd, dim3(grid), dim3(NTHR), kargs, LDS_BYTES, stream);
    if (e != hipSuccess) fprintf(stderr, "kernel_launch: cooperative launch failed: %s (grid %d)\n", hipGetErrorString(e), grid);
#else
    for (int p = 0; p < 11; ++p) { a.ph_lo = p; a.ph_hi = p + 1; hipLaunchKernelGGL(mk_fwd, dim3(grid), dim3(NTHR), LDS_BYTES, stream, a); }
#endif
}
```

```cpp
#include <hip/hip_runtime.h>
#include <hip/hip_cooperative_groups.h>
#include <cstdio>
#include <cstdint>
namespace cg = cooperative_groups;
#define B_FAST 1
#define B_QK 1
#define B_BF16 1
namespace pg8 {
#define PG8_LAS __attribute__((address_space(3)))
typedef unsigned short bf16_t;
typedef short bf16x8 __attribute__((ext_vector_type(8)));
typedef float f32x4 __attribute__((ext_vector_type(4)));
typedef unsigned u32x4 __attribute__((ext_vector_type(4)));
constexpr int BM = 256, BK = 64, HALF = 128, HTB = HALF * BK * 2  , STAGE_BYTES = 8 * HTB, NXCD = 8, WGM = 8;

__host__ __device__ __forceinline__ int lds_byte(int r, int c) { const int st = (r >> 4) * 2 + (c >> 5), rr = r & 15, cc = c & 31, ob = rr * 64 + cc * 2; return st * 1024 + (ob ^ (((ob >> 9) & 1) << 5)); }
__host__ __device__ __forceinline__ void stage_rc(int b, int& R, int& C) { const int st = b / 1024, sb = b % 1024, swz = sb ^ (((sb >> 9) & 1) << 5); R = (st >> 1) * 16 + swz / 64; C = (st & 1) * 32 + (swz % 64) / 2; }
__host__ __device__ __forceinline__ int perm32(int rho) { const int n = rho >> 4, i = rho & 15; return 8 * (i >> 2) + 4 * n + (i & 3); }

struct Unit { int pm, pn; };
struct Gemm { const bf16_t* A; const bf16_t* Bt; int M, N, K; };

struct StaticOrder {
    int nM, nN, nwg, G, c;
    __host__ __device__ void init(int M, int N, int G_, int c_) { nM = M / BM; nN = N / BM; nwg = nM * nN; G = G_; c = c_; }
    __host__ __device__ bool next(int i, Unit& u) const {
        const long L = (long)i * G + c; if (L >= nwg) return false;
        int wgid = (int)L; { const int q = nwg / NXCD, r = nwg % NXCD, xcd = wgid % NXCD, off = wgid / NXCD; wgid = (xcd < r ? xcd * (q + 1) : r * (q + 1) + (xcd - r) * q) + off; }
        const int nig = WGM * nN, gid = wgid / nig, fm = gid * WGM, gsz = (nM - fm) < WGM ? (nM - fm) : WGM;
        u.pm = fm + ((wgid % nig) % gsz); u.pn = (wgid % nig) / gsz; return true;
    }
    __device__ __forceinline__ void a_ready(const Unit&) const {}
    __device__ __forceinline__ void done(const Unit&) const {}
};

typedef __bf16 bf16x2_cv __attribute__((ext_vector_type(2)));
typedef float f32x2_cv __attribute__((ext_vector_type(2)));
__device__ __forceinline__ unsigned cvt_pk_bf16(float lo, float hi) { const f32x2_cv f = {lo, hi}; const bf16x2_cv b = __builtin_convertvector(f, bf16x2_cv); return __builtin_bit_cast(unsigned, b); }
typedef float f32x2 __attribute__((ext_vector_type(2)));
constexpr float RMS_EPS = 1e-6f;
typedef unsigned u32x2 __attribute__((ext_vector_type(2)));
__device__ __forceinline__ float silu_f(float g) { return g * __builtin_amdgcn_rcpf(1.0f + __builtin_amdgcn_exp2f(-1.44269504089f * g)); }

struct EpiSwiGLU {
    static constexpr bool PERM = true, AFTER_DRAIN = false;
    bf16_t* O; int ldc; const float* rowss; float inv_d;
    __device__ __forceinline__ void operator()(const f32x4 (&acc)[2][2][4][2], const Unit& u, int wr, int wc, int fr, int fq) const {
        const int row0 = u.pm * BM + wr * 64 + fr, col0 = u.pn * HALF + wc * 32 + 8 * fq;
#pragma unroll
        for (int ai = 0; ai < 2; ++ai)
#pragma unroll
            for (int m = 0; m < 4; ++m) {
                const int row = row0 + ai * HALF + m * 16;
                const float rs = rsqrtf(rowss[row] * inv_d + RMS_EPS);
                const f32x4 g0 = acc[ai][0][m][0] * rs, g1 = acc[ai][0][m][1] * rs, u0 = acc[ai][1][m][0] * rs, u1 = acc[ai][1][m][1] * rs;
                u32x4 w;
                w.x = cvt_pk_bf16(silu_f(g0[0]) * u0[0], silu_f(g0[1]) * u0[1]); w.y = cvt_pk_bf16(silu_f(g0[2]) * u0[2], silu_f(g0[3]) * u0[3]);
                w.z = cvt_pk_bf16(silu_f(g1[0]) * u1[0], silu_f(g1[1]) * u1[1]); w.w = cvt_pk_bf16(silu_f(g1[2]) * u1[2], silu_f(g1[3]) * u1[3]);
                *(u32x4*)(O + (size_t)row * ldc + col0) = w;
            }
    }
};
struct EpiScaleBf16 {
    static constexpr bool PERM = true, AFTER_DRAIN = false;
    bf16_t* O; int ldc; const float* rowss; float inv_d;
    __device__ __forceinline__ void operator()(const f32x4 (&acc)[2][2][4][2], const Unit& u, int wr, int wc, int fr, int fq) const {
        const int row0 = u.pm * BM + wr * 64 + fr, col0 = u.pn * BM + wc * 32 + 8 * fq;
#pragma unroll
        for (int ai = 0; ai < 2; ++ai)
#pragma unroll
            for (int m = 0; m < 4; ++m) {
                const int row = row0 + ai * HALF + m * 16;
                const float rs = rsqrtf(rowss[row] * inv_d + RMS_EPS);
                bf16_t* rowp = O + (size_t)row * ldc + col0;
#pragma unroll
                for (int bj = 0; bj < 2; ++bj) { const f32x4 v0 = acc[ai][bj][m][0] * rs, v1 = acc[ai][bj][m][1] * rs;
                    u32x4 w; w.x = cvt_pk_bf16(v0[0], v0[1]); w.y = cvt_pk_bf16(v0[2], v0[3]); w.z = cvt_pk_bf16(v1[0], v1[1]); w.w = cvt_pk_bf16(v1[2], v1[3]);
                    *(u32x4*)(rowp + bj * HALF) = w; }
            }
    }
};
struct EpiResid {
    static constexpr bool PERM = false, AFTER_DRAIN = false;
    const float* base; float* out; float alpha; bf16_t* HG; const float* gvec; float* rowss_out;
    __device__ __forceinline__ void operator()(const f32x4 (&acc)[2][2][4][2], const Unit& u, int wr, int wc, int fr, int fq) const {
        const int row0 = u.pm * BM + wr * 64 + fr, col0 = u.pn * BM + wc * 32 + 4 * fq;
        f32x4 gv[2][2];
#pragma unroll
        for (int bj = 0; bj < 2; ++bj)
#pragma unroll
            for (int n = 0; n < 2; ++n) gv[bj][n] = HG ? *(const f32x4*)(gvec + col0 + bj * HALF + n * 16) : (f32x4){0.f, 0.f, 0.f, 0.f};
#pragma unroll
        for (int ai = 0; ai < 2; ++ai)
#pragma unroll
            for (int m = 0; m < 4; ++m) {
                const int row = row0 + ai * HALF + m * 16; const size_t off = (size_t)row * 2048 + col0; float ss = 0.f;
#pragma unroll
                for (int bj = 0; bj < 2; ++bj)
#pragma unroll
                    for (int n = 0; n < 2; ++n) {
                        const f32x4 b = *(const f32x4*)(base + off + bj * HALF + n * 16);
                        const f32x4 h = b + acc[ai][bj][m][n] * alpha;
                        *(f32x4*)(out + off + bj * HALF + n * 16) = h;
                        ss += (h[0] * h[0] + h[1] * h[1]) + (h[2] * h[2] + h[3] * h[3]);
                        if (HG) { const f32x4 t = h * gv[bj][n]; u32x2 w; w.x = cvt_pk_bf16(t[0], t[1]); w.y = cvt_pk_bf16(t[2], t[3]); *(u32x2*)(HG + off + bj * HALF + n * 16) = w; }
                    }
                ss += __shfl_xor(ss, 16); ss += __shfl_xor(ss, 32);
                if (fq == 0) atomicAdd(rowss_out + row, ss);
                if (m & 1) asm volatile("" ::: "memory");
            }
    }
};
template <class Epi, class Sched, bool ALIGN_EPI = false, bool SP2 = false>
__device__ __forceinline__ void gemm_phase(PG8_LAS unsigned char* lds, const Gemm g, const Sched& S, const Epi& E) {
    const int tid = threadIdx.x, wid = __builtin_amdgcn_readfirstlane(tid >> 6), lane = tid & 63, wr = wid >> 2, wc = wid & 3, fr = lane & 15, fq = lane >> 4;
    const int K = g.K, nt = K / BK;
    unsigned voffA[2], voffB[2];
#pragma unroll
    for (int i = 0; i < 2; ++i) { int R, C; stage_rc(tid * 16 + i * 8192, R, C); const int Rb = Epi::PERM ? ((R & ~31) + perm32(R & 31)) : R;
        voffA[i] = (unsigned)(R * K + C) * 2u; voffB[i] = (unsigned)(Rb * K + C) * 2u; }
    const size_t kstep = (size_t)(BK * 2);
    const size_t hstep = (size_t)HALF * K * 2;
    const size_t tstep = 2 * hstep;
    const unsigned ldsw = (unsigned)wid * 1024u;
    const int aoff = lds_byte(wr * 64 + fr, fq * 8), boff = lds_byte(wc * 32 + fr, fq * 8);
#define PG8_SA(b, h) (((b) * 2 + (h)) * HTB)
#define PG8_SB(b, h) ((4 + (b) * 2 + (h)) * HTB)
#define PG8_STAGE(bufoff, gbase, voff) do { _Pragma("unroll") for (int _i = 0; _i < 2; ++_i) \
        __builtin_amdgcn_global_load_lds((const unsigned*)((const char*)(gbase) + (voff)[_i]), (PG8_LAS unsigned*)(lds + (bufoff) + ldsw + _i * 8192), 16, 0, 0); } while (0)
#define PG8_LDA(dst, b, h) do { _Pragma("unroll") for (int m = 0; m < 4; ++m) _Pragma("unroll") for (int k = 0; k < 2; ++k) dst[m][k] = *(const PG8_LAS bf16x8*)(lds + PG8_SA(b, h) + aoff + m * 2048 + k * 1024); } while (0)
#define PG8_LDB(dst, b, h) do { _Pragma("unroll") for (int n = 0; n < 2; ++n) _Pragma("unroll") for (int k = 0; k < 2; ++k) dst[n][k] = *(const PG8_LAS bf16x8*)(lds + PG8_SB(b, h) + boff + n * 2048 + k * 1024); } while (0)
#define PG8_MMA(ai, bj, At, Bt) do { __builtin_amdgcn_s_setprio(1); _Pragma("unroll") for (int m = 0; m < 4; ++m) _Pragma("unroll") for (int n = 0; n < 2; ++n) _Pragma("unroll") for (int k = 0; k < 2; ++k) \
        acc[ai][bj][m][n] = __builtin_amdgcn_mfma_f32_16x16x32_bf16(Bt[n][k], At[m][k], acc[ai][bj][m][n], 0, 0, 0); __builtin_amdgcn_s_setprio(0); } while (0)
#define PG8_WAIT_V(n) asm volatile("s_waitcnt vmcnt(" #n ")" ::: "memory")
#define PG8_WAIT_L(n) asm volatile("s_waitcnt lgkmcnt(" #n ")" ::: "memory")
#define PG8_BAR __builtin_amdgcn_s_barrier()
#define PG8_SCHED __builtin_amdgcn_sched_barrier(0)
    Unit cur, nxt; int ui = 0;
    if (!S.next(0, cur)) return;
    f32x4 acc[2][2][4][2];
#pragma unroll
    for (int a = 0; a < 2; ++a)
#pragma unroll
        for (int b = 0; b < 2; ++b)
#pragma unroll
            for (int m = 0; m < 4; ++m)
#pragma unroll
                for (int n = 0; n < 2; ++n) acc[a][b][m][n] = (f32x4){0.f, 0.f, 0.f, 0.f};
    bf16x8 At[4][2], B0[2][2], B1[2][2];
    const char* cA = (const char*)g.A + (size_t)cur.pm * tstep; const char* cB = (const char*)g.Bt + (size_t)cur.pn * tstep;
    S.a_ready(cur);
    if constexpr (SP2) {
        PG8_STAGE(PG8_SB(0, 0), cB, voffB); PG8_STAGE(PG8_SB(0, 1), cB + hstep, voffB); PG8_STAGE(PG8_SA(0, 0), cA, voffA); PG8_STAGE(PG8_SA(0, 1), cA + hstep, voffA);
        if (wr == 1) PG8_BAR;
        PG8_WAIT_V(2); PG8_BAR;
        PG8_STAGE(PG8_SB(1, 0), cB + kstep, voffB); PG8_STAGE(PG8_SA(1, 0), cA + kstep, voffA); PG8_STAGE(PG8_SB(1, 1), cB + hstep + kstep, voffB);
        PG8_WAIT_V(6); PG8_BAR;
    } else {
        PG8_STAGE(PG8_SB(0, 0), cB, voffB); PG8_STAGE(PG8_SA(0, 0), cA, voffA); PG8_STAGE(PG8_SB(0, 1), cB + hstep, voffB); PG8_STAGE(PG8_SA(0, 1), cA + hstep, voffA);
        if (wr == 1) PG8_BAR;
        PG8_WAIT_V(4); PG8_BAR;
        PG8_STAGE(PG8_SB(1, 0), cB + kstep, voffB); PG8_STAGE(PG8_SA(1, 0), cA + kstep, voffA); PG8_STAGE(PG8_SB(1, 1), cB + hstep + kstep, voffB);
        PG8_WAIT_V(6); PG8_BAR;
    }
    for (;;) {
        const bool has_next = S.next(ui + 1, nxt);
        const char* nA = has_next ? (const char*)g.A + (size_t)nxt.pm * tstep : cA; const char* nB = has_next ? (const char*)g.Bt + (size_t)nxt.pn * tstep : cB;
        for (int t = 0; t < nt; t += 2) {
            const bool last = (t == nt - 2);
            const char* a1 = cA + (size_t)(t + 1) * kstep;
            const char* a2 = last ? nA : cA + (size_t)(t + 2) * kstep; const char* b2 = last ? nB : cB + (size_t)(t + 2) * kstep;
            const char* a3 = a2 + kstep; const char* b3 = b2 + kstep;
            if (last && has_next) S.a_ready(nxt);
            if constexpr (SP2) {
            PG8_LDB(B0, 0, 0); PG8_LDB(B1, 0, 1); PG8_SCHED; PG8_LDA(At, 0, 0); PG8_STAGE(PG8_SA(1, 1), a1 + hstep, voffA);
            PG8_WAIT_V(8); PG8_WAIT_L(0); PG8_BAR; PG8_MMA(0, 0, At, B0); PG8_MMA(0, 1, At, B1); PG8_BAR; PG8_SCHED;
            PG8_LDA(At, 0, 1); PG8_STAGE(PG8_SB(0, 0), b2, voffB); PG8_STAGE(PG8_SB(0, 1), b2 + hstep, voffB); PG8_STAGE(PG8_SA(0, 0), a2, voffA);
            PG8_WAIT_V(8); PG8_WAIT_L(0); PG8_BAR; PG8_MMA(1, 0, At, B0); PG8_MMA(1, 1, At, B1); PG8_BAR; PG8_SCHED;
            PG8_LDB(B0, 1, 0); PG8_LDB(B1, 1, 1); PG8_SCHED; PG8_LDA(At, 1, 0); PG8_STAGE(PG8_SA(0, 1), a2 + hstep, voffA);
            PG8_WAIT_V(8); PG8_WAIT_L(0); PG8_BAR; PG8_MMA(0, 0, At, B0); PG8_MMA(0, 1, At, B1); PG8_BAR; PG8_SCHED;
            PG8_LDA(At, 1, 1); PG8_STAGE(PG8_SB(1, 0), b3, voffB); PG8_STAGE(PG8_SB(1, 1), b3 + hstep, voffB); PG8_STAGE(PG8_SA(1, 0), a3, voffA);
            PG8_WAIT_V(8); PG8_WAIT_L(0); PG8_BAR; PG8_MMA(1, 0, At, B0); PG8_MMA(1, 1, At, B1); PG8_BAR; PG8_SCHED;
            } else {
            PG8_LDB(B0, 0, 0); PG8_SCHED; PG8_LDA(At, 0, 0); PG8_STAGE(PG8_SA(1, 1), a1 + hstep, voffA);
            PG8_WAIT_L(8); PG8_BAR; PG8_WAIT_L(0); PG8_MMA(0, 0, At, B0); PG8_BAR; PG8_SCHED;
            PG8_LDB(B1, 0, 1); PG8_STAGE(PG8_SB(0, 0), b2, voffB);
            PG8_BAR; PG8_WAIT_L(0); PG8_MMA(0, 1, At, B1); PG8_BAR;
            PG8_LDA(At, 0, 1); PG8_STAGE(PG8_SA(0, 0), a2, voffA);
            PG8_BAR; PG8_WAIT_L(0); PG8_MMA(1, 0, At, B0); PG8_BAR; PG8_SCHED;
            PG8_STAGE(PG8_SB(0, 1), b2 + hstep, voffB);
            PG8_WAIT_V(6); PG8_BAR; PG8_MMA(1, 1, At, B1); PG8_BAR;
            PG8_LDB(B0, 1, 0); PG8_SCHED; PG8_LDA(At, 1, 0); PG8_STAGE(PG8_SA(0, 1), a2 + hstep, voffA);
            PG8_WAIT_L(8); PG8_BAR; PG8_WAIT_L(0); PG8_MMA(0, 0, At, B0); PG8_BAR; PG8_SCHED;
            PG8_LDB(B1, 1, 1); PG8_STAGE(PG8_SB(1, 0), b3, voffB);
            PG8_BAR; PG8_WAIT_L(0); PG8_MMA(0, 1, At, B1); PG8_BAR;
            PG8_LDA(At, 1, 1); PG8_STAGE(PG8_SA(1, 0), a3, voffA);
            PG8_BAR; PG8_WAIT_L(0); PG8_MMA(1, 0, At, B0); PG8_BAR; PG8_SCHED;
            PG8_STAGE(PG8_SB(1, 1), b3 + hstep, voffB);
            PG8_WAIT_V(6); PG8_BAR; PG8_MMA(1, 1, At, B1); PG8_BAR;
            }
        }
        if constexpr (ALIGN_EPI) { if (wr == 0) PG8_BAR; }
        if constexpr (!Epi::AFTER_DRAIN) { E(acc, cur, wr, wc, fr, fq); S.done(cur); }
        if (!has_next) break;
#pragma unroll
        for (int a = 0; a < 2; ++a)
#pragma unroll
            for (int b = 0; b < 2; ++b)
#pragma unroll
                for (int m = 0; m < 4; ++m)
#pragma unroll
                    for (int n = 0; n < 2; ++n) acc[a][b][m][n] = (f32x4){0.f, 0.f, 0.f, 0.f};
        cur = nxt; cA = nA; cB = nB; ++ui;
        if constexpr (ALIGN_EPI) { if (wr == 1) PG8_BAR; }
    }
    PG8_WAIT_V(0);
    if constexpr (!ALIGN_EPI) { if (wr == 0) PG8_BAR; }
    PG8_BAR;
    if constexpr (Epi::AFTER_DRAIN) { E.fused(acc, cur, wr, wc, fr, fq, lds, wid, lane); S.done(cur); }
#undef PG8_SA
#undef PG8_SB
#undef PG8_STAGE
#undef PG8_LDA
#undef PG8_LDB
#undef PG8_MMA
#undef PG8_WAIT_V
#undef PG8_WAIT_L
#undef PG8_BAR
#undef PG8_SCHED
}
}
using pg8::bf16_t; using pg8::bf16x8; using pg8::f32x4; using pg8::u32x4; using pg8::u32x2; using pg8::cvt_pk_bf16; using pg8::silu_f; using pg8::RMS_EPS;
#define LAS __attribute__((address_space(3)))
#define LDS_WAIT() asm volatile("s_waitcnt lgkmcnt(0)" ::: "memory")

constexpr int DM = 2048, SEQ = 2048, M = 8192, DFF = 5632, DIN = 4112, DU = 4096;
constexpr int OQ = 1024, OKK = 1536, OV = 2048, OG = 3072;
constexpr int NWAVES = 8, NTHR = 512;
constexpr float INV_DM = 1.0f / 2048.0f;

constexpr size_t MiB = 1u << 20;
constexpr size_t WS_ROWSS = 0;
constexpr size_t WS_GL = 256 * 1024;
constexpr size_t WS_DEC = 1 * MiB;
constexpr size_t WS_W1IN = 2 * MiB, WS_W1OUT = 46 * MiB, WS_WMIX = 68 * MiB, WS_WPOOL = 85 * MiB, WS_WOUT = 86 * MiB, WS_W2IN = 94 * MiB, WS_W2OUT = 138 * MiB;
constexpr size_t WS_A = 160 * MiB, WS_ACT = 192 * MiB, WS_U = 192 * MiB, WS_Y = 256 * MiB, WS_KVT = 2 * MiB  , WS_ST = 288 * MiB  , WS_QD = 352 * MiB  , WS_KI = 360 * MiB, WS_END = 368 * MiB;

constexpr int RING_BYTES = 131072, LDS_BYTES = 147456;

__device__ __forceinline__ unsigned f2bf(float f) { unsigned u = __builtin_bit_cast(unsigned, f); return (u + 0x7fffu + ((u >> 16) & 1u)) >> 16; }
__device__ __forceinline__ unsigned pk2(float lo, float hi) { return f2bf(lo) | (f2bf(hi) << 16); }
__device__ __forceinline__ float bf_lo(unsigned v) { return __builtin_bit_cast(float, v << 16); }
__device__ __forceinline__ float bf_hi(unsigned v) { return __builtin_bit_cast(float, v & 0xffff0000u); }
__device__ __forceinline__ float wave_sum(float v) {
#pragma unroll
    for (int o = 1; o < 64; o <<= 1) v += __shfl_xor(v, o);
    return v;
}
#define MFMA16(a, b, c) __builtin_amdgcn_mfma_f32_16x16x32_bf16((a), (b), (c), 0, 0, 0)

__device__ __forceinline__ int swiglu_row(int n) { return n < DFF ? ((n >> 7) * 256 + (n & 127)) : (((n - DFF) >> 7) * 256 + 128 + ((n - DFF) & 127)); }
__device__ __forceinline__ void transpose_item(const float* W, int K, int N, bf16_t* WT, int mode, LAS float* scr, int item, int lane) {
    const int nblk = (N + 31) / 32, kb = item / nblk, nb = item % nblk, k0 = 64 * kb, n0 = 32 * nb;
    const int rsub = lane >> 3, n4 = (lane & 7) * 4; const bool ok = (n0 + n4) < N;
    f32x4 v[8];
#pragma unroll
    for (int i = 0; i < 8; ++i) v[i] = ok ? *(const f32x4*)(W + (size_t)(k0 + 8 * i + rsub) * N + n0 + n4) : (f32x4){0.f, 0.f, 0.f, 0.f};
#pragma unroll
    for (int i = 0; i < 8; ++i) { LAS float* d = scr + (8 * i + rsub) * 33 + n4; d[0] = v[i][0]; d[1] = v[i][1]; d[2] = v[i][2]; d[3] = v[i][3]; }
    LDS_WAIT();
    const int c = lane & 7;
#pragma unroll
    for (int j = 0; j < 4; ++j) { const int n = (lane >> 3) + 8 * j; const LAS float* s = scr + (8 * c) * 33 + n;
        u32x4 o; o.x = pk2(s[0 * 33], s[1 * 33]); o.y = pk2(s[2 * 33], s[3 * 33]); o.z = pk2(s[4 * 33], s[5 * 33]); o.w = pk2(s[6 * 33], s[7 * 33]);
        const int nn = n0 + n;
        if (nn < N) { const int drow = mode == 1 ? swiglu_row(nn) : nn; *(u32x4*)(WT + (size_t)drow * K + k0 + 8 * c) = o; } }
    LDS_WAIT();
}

struct Args { const float* in[16]; float* out; unsigned char* ws; int ph_lo, ph_hi; };

__device__ __forceinline__ void p0_prologue(const Args& a, LAS unsigned char* lds, int gw, int NGW, int lane, int wave) {
    unsigned char* ws = a.ws;
    LAS float* scr = (LAS float*)(lds + wave * 16384);
    constexpr int I_IN = (DM / 64) * (2 * DFF / 32), I_OUT = (DFF / 64) * (DM / 32), I_MIX = (DM / 64) * ((DIN + 31) / 32), I_POOL1 = (256 / 64) * (256 / 32), I_O = (DM / 64) * (DM / 32);
    constexpr int NITEMS = 2 * I_IN + 2 * I_OUT + I_MIX + 4 * I_POOL1 + I_O;
    for (int it = gw; it < NITEMS; it += NGW) {
        int r = it;
        if (r < I_IN) { transpose_item(a.in[2], DM, 2 * DFF, (bf16_t*)(ws + WS_W1IN), 1, scr, r, lane); continue; } r -= I_IN;
        if (r < I_OUT) { transpose_item(a.in[3], DFF, DM, (bf16_t*)(ws + WS_W1OUT), 0, scr, r, lane); continue; } r -= I_OUT;
        if (r < I_MIX) { transpose_item(a.in[5], DM, DIN, (bf16_t*)(ws + WS_WMIX), 0, scr, r, lane); continue; } r -= I_MIX;
        if (r < 4 * I_POOL1) { const int g = r / I_POOL1; transpose_item(a.in[6] + g * 65536, 256, 256, (bf16_t*)(ws + WS_WPOOL) + g * 65536, 0, scr, r % I_POOL1, lane); continue; } r -= 4 * I_POOL1;
        if (r < I_O) { transpose_item(a.in[11], DM, DM, (bf16_t*)(ws + WS_WOUT), 0, scr, r, lane); continue; } r -= I_O;
        if (r < I_IN) { transpose_item(a.in[13], DM, 2 * DFF, (bf16_t*)(ws + WS_W2IN), 1, scr, r, lane); continue; } r -= I_IN;
        transpose_item(a.in[14], DFF, DM, (bf16_t*)(ws + WS_W2OUT), 0, scr, r, lane);
    }
    const float* x = a.in[0]; const float* g1 = a.in[1]; bf16_t* A = (bf16_t*)(ws + WS_A); float* rowss = (float*)(ws + WS_ROWSS);
    for (int m = gw; m < M; m += NGW) {
        const f32x4* xr = (const f32x4*)(x + (size_t)m * DM) + lane; const f32x4* gr = (const f32x4*)g1 + lane;
        u32x2* o = (u32x2*)(A + (size_t)m * DM) + lane; float s = 0.f;
#pragma unroll
        for (int j = 0; j < 8; ++j) { const f32x4 v = xr[64 * j]; const f32x4 g = gr[64 * j]; s += (v[0] * v[0] + v[1] * v[1]) + (v[2] * v[2] + v[3] * v[3]);
            u32x2 w; w.x = cvt_pk_bf16(v[0] * g[0], v[1] * g[1]); w.y = cvt_pk_bf16(v[2] * g[2], v[3] * g[3]); o[64 * j] = w; }
        s = wave_sum(s);
        if (lane == 0) { rowss[m] = s; rowss[M + m] = 0.f; rowss[2 * M + m] = 0.f; rowss[3 * M + m] = 0.f; }
    }
}

__device__ __forceinline__ void gatelr_phase(const bf16_t* A, const bf16_t* WTr, const float* rowss, float* GL, LAS unsigned char* lds, int G, int tid, int wave, int lane) {
    const int fr = lane & 15, fq = lane >> 4, tg = wave >> 2, kq = wave & 3;
    LAS float* P = (LAS float*)lds;
    for (int tb = blockIdx.x; tb < M / 32; tb += G) {
        const int t0 = 32 * tb;
        const bf16_t* ap = A + (size_t)(t0 + 16 * tg + fr) * DM + kq * 512 + 8 * fq;
        const bf16_t* bp = WTr + (size_t)fr * DM + kq * 512 + 8 * fq;
        f32x4 acc = {0.f, 0.f, 0.f, 0.f};
#pragma unroll 8
        for (int ks = 0; ks < 16; ++ks) { const bf16x8 av = *(const bf16x8*)(ap + 32 * ks); const bf16x8 bv = *(const bf16x8*)(bp + 32 * ks); acc = MFMA16(av, bv, acc); }
        *(LAS f32x4*)(P + (wave * 64 + lane) * 4) = acc;
        __syncthreads();
        { const int tok = tid >> 4, r = tid & 15, tg2 = tok >> 4, tl = tok & 15, ln = r + 16 * (tl >> 2), j = tl & 3; float s = 0.f;
#pragma unroll
          for (int q = 0; q < 4; ++q) s += P[((tg2 * 4 + q) * 64 + ln) * 4 + j];
          GL[(size_t)(t0 + tok) * 16 + r] = s * rsqrtf(rowss[t0 + tok] * INV_DM + RMS_EPS); }
        __syncthreads();
    }
}

__device__ __forceinline__ void pool_task(int task, const bf16_t* U, const bf16_t* WpT, const float* pool_scale, bf16_t* Y, LAS unsigned char* lds, int tid, int wave, int lane) {
    const int tt = task >> 2, g = task & 3, T0 = 64 * tt, p0 = T0 % SEQ, w = 2 << g;
    const int fr = lane & 15, fq = lane >> 4;
    LAS bf16_t* UL = (LAS bf16_t*)lds;
    LAS bf16_t* PA = (LAS bf16_t*)(lds + 40960);
#pragma unroll
    for (int i = 0; i < 5; ++i) { const int ch = tid + 512 * i, r = ch >> 5, c16 = ch & 31, pos = p0 - 16 + r;
        u32x4 v = {0u, 0u, 0u, 0u};
        if (pos >= 0) v = *(const u32x4*)(U + (size_t)(T0 - 16 + r) * DU + g * 256 + c16 * 8);
        *(LAS u32x4*)(UL + r * 256 + c16 * 8) = v; }
    __syncthreads();
    {
        const int cp = tid & 127, tq = tid >> 7, i0 = 16 * tq;
        const LAS unsigned* UL32 = (const LAS unsigned*)UL; LAS unsigned* PA32 = (LAS unsigned*)PA;
        float s0 = 0.f, s1 = 0.f;
        for (int s = i0 - w + 1; s < i0; ++s) { const unsigned v = UL32[(s + 16) * 128 + cp]; s0 += bf_lo(v); s1 += bf_hi(v); }
        for (int i = i0; i < i0 + 16; ++i) {
            const unsigned v = UL32[(i + 16) * 128 + cp]; const float a0 = bf_lo(v), a1 = bf_hi(v);
            s0 += a0; s1 += a1;
            const int pos = p0 + i; const int cnt = (pos + 1) < w ? (pos + 1) : w; const float inv = 1.0f / (float)cnt;
            PA32[i * 132 + cp] = cvt_pk_bf16(s0 * inv - a0, s1 * inv - a1);
            const unsigned o = UL32[(i - w + 1 + 16) * 128 + cp]; s0 -= bf_lo(o); s1 -= bf_hi(o);
        }
    }
    __syncthreads();
    f32x4 acc[4][2];
#pragma unroll
    for (int mt = 0; mt < 4; ++mt)
#pragma unroll
        for (int nt = 0; nt < 2; ++nt) acc[mt][nt] = (f32x4){0.f, 0.f, 0.f, 0.f};
    const bf16_t* wp = WpT + (size_t)g * 65536 + (size_t)(32 * wave + fr) * 256 + 8 * fq;
#pragma unroll
    for (int ks = 0; ks < 8; ++ks) {
        bf16x8 wf[2];
#pragma unroll
        for (int nt = 0; nt < 2; ++nt) wf[nt] = *(const bf16x8*)(wp + nt * 16 * 256 + 32 * ks);
#pragma unroll
        for (int mt = 0; mt < 4; ++mt) { const bf16x8 af = *(const LAS bf16x8*)(PA + (16 * mt + fr) * 264 + 32 * ks + 8 * fq);
#pragma unroll
            for (int nt = 0; nt < 2; ++nt) acc[mt][nt] = MFMA16(wf[nt], af, acc[mt][nt]); }
    }
#pragma unroll
    for (int nt = 0; nt < 2; ++nt) { const int n = 32 * wave + 16 * nt + 4 * fq; const f32x4 sc = *(const f32x4*)(pool_scale + g * 256 + n);
#pragma unroll
        for (int mt = 0; mt < 4; ++mt) { const f32x4 v = acc[mt][nt] * sc; u32x2 o; o.x = cvt_pk_bf16(v[0], v[1]); o.y = cvt_pk_bf16(v[2], v[3]);
            *(u32x2*)(Y + (size_t)(T0 + 16 * mt + fr) * DM + g * 256 + n) = o; } }
    __syncthreads();
}

#ifndef B_FAST
#define B_FAST 1
#endif
#ifndef B_QK
#define B_QK 1
#endif
#ifndef B_BF16
#define B_BF16 1
#endif
#if B_FAST
__device__ __forceinline__ float fexp(float x) { return __builtin_amdgcn_exp2f(x * 1.44269504089f); }
__device__ __forceinline__ float flog1pexp(float na) { return __builtin_amdgcn_logf(1.0f + fexp(na)) * 0.69314718056f; }
#else
__device__ __forceinline__ float fexp(float x) { return expf(x); }
__device__ __forceinline__ float flog1pexp(float na) { return log1pf(expf(na)); }
#endif
#ifndef B_KV16
#define B_KV16 B_BF16
#endif
#ifndef B_ST16
#define B_ST16 B_BF16
#endif
#if B_KV16
typedef bf16_t kv_t;
#else
typedef float kv_t;
#endif
#if B_ST16
typedef bf16_t st_t;
#else
typedef float st_t;
#endif
__device__ __forceinline__ void gla_bcum(const float* GL, const float* w_alpha, const float* b_alpha, int T0, int h, LAS float* GLs, LAS float* BC, LAS float* SEG, int tid) {
    for (int i = tid; i < 1024; i += NTHR) GLs[i] = GL[(size_t)T0 * 16 + i];
    const int d = tid & 127, q = tid >> 7;
    float wa[16];
#pragma unroll
    for (int r = 0; r < 16; ++r) wa[r] = w_alpha[r * 512 + h * 128 + d];
    const float ba = b_alpha[h * 128 + d];
    __syncthreads();
    float c = 0.f;
#pragma unroll 4
    for (int tt = 0; tt < 16; ++tt) { const int t = 16 * q + tt; float z = ba;
#pragma unroll
        for (int r = 0; r < 16; ++r) z += GLs[t * 16 + r] * wa[r];
        const float ls = fminf(z, 0.f) - flog1pexp(-fabsf(z));
        c += ls * 0.0625f; BC[t * 128 + d] = c; }
    SEG[q * 128 + d] = c;
    __syncthreads();
    float off = 0.f;
    for (int qq = 0; qq < q; ++qq) off += SEG[qq * 128 + d];
    if (q > 0) {
#pragma unroll 4
        for (int tt = 0; tt < 16; ++tt) BC[(16 * q + tt) * 128 + d] += off; }
    __syncthreads();
}
__device__ __forceinline__ u32x4 pack8(const unsigned (&b)[8]) { u32x4 o; o.x = b[0] | (b[1] << 16); o.y = b[2] | (b[3] << 16); o.z = b[4] | (b[5] << 16); o.w = b[6] | (b[7] << 16); return o; }
__device__ __forceinline__ void gla_stage_vt(const bf16_t* U, int T0, int h, LAS bf16_t* VT, int tid) {
    const int dvp = tid & 127, cgrp = tid >> 7;
#pragma unroll
    for (int hf = 0; hf < 2; ++hf) { const int c8 = 16 * cgrp + 8 * hf; unsigned a[8], b[8];
#pragma unroll
        for (int cc = 0; cc < 8; ++cc) { const unsigned vv = *(const unsigned*)(U + (size_t)(T0 + c8 + cc) * DU + OV + h * 256 + 2 * dvp); a[cc] = vv & 0xffffu; b[cc] = vv >> 16; }
        *(LAS u32x4*)(VT + (2 * dvp) * 72 + c8) = pack8(a); *(LAS u32x4*)(VT + (2 * dvp + 1) * 72 + c8) = pack8(b); }
}
constexpr int GL_OFF = 0, BC_OFF = 4096, SEG_OFF = 36864;
__device__ __forceinline__ void gla_kv_task(int task, const bf16_t* U, const float* GL, const float* w_alpha, const float* b_alpha, kv_t* KVT, float* DEC, bf16_t* QDg, bf16_t* KIg, LAS unsigned char* lds, int tid, int wave, int lane) {
    const int b = task >> 7, h = (task >> 5) & 3, n = task & 31, T0 = b * SEQ + n * 64;
    const int fr = lane & 15, fq = lane >> 4;
    LAS float* GLs = (LAS float*)(lds + GL_OFF); LAS float* BC = (LAS float*)(lds + BC_OFF); LAS float* SEG = (LAS float*)(lds + SEG_OFF);
    LAS bf16_t* KT = (LAS bf16_t*)(lds + 38912);
    LAS bf16_t* VT = (LAS bf16_t*)(lds + 57344);
    gla_bcum(GL, w_alpha, b_alpha, T0, h, GLs, BC, SEG, tid);
    { const int dp = tid & 63, cg8 = tid >> 6; const float bl0 = BC[63 * 128 + 2 * dp], bl1 = BC[63 * 128 + 2 * dp + 1]; unsigned k0[8], k1[8];
#pragma unroll
      for (int cc = 0; cc < 8; ++cc) { const int c = 8 * cg8 + cc; const bf16_t* up = U + (size_t)(T0 + c) * DU + h * 128 + 2 * dp;
          const unsigned k2 = *(const unsigned*)(up + OKK); const float b0 = BC[c * 128 + 2 * dp], b1 = BC[c * 128 + 2 * dp + 1];
          const float kl = bf_lo(k2), kh = bf_hi(k2);
          k0[cc] = f2bf(kl * fexp(bl0 - b0)); k1[cc] = f2bf(kh * fexp(bl1 - b1));
#if B_QK
          const unsigned q2 = *(const unsigned*)(up + OQ); const float qs = 0.08838834764831845f;
          *(unsigned*)(QDg + (size_t)(T0 + c) * 512 + h * 128 + 2 * dp) = cvt_pk_bf16(bf_lo(q2) * qs * fexp(b0), bf_hi(q2) * qs * fexp(b1));
          *(unsigned*)(KIg + (size_t)(T0 + c) * 512 + h * 128 + 2 * dp) = cvt_pk_bf16(kl * fexp(-b0), kh * fexp(-b1));
#endif
      }
      const int dk = 2 * dp;
#if B_KV16
      const int slot = (dk & ~31) | (((dk >> 2) & 1) << 4) | (((dk >> 3) & 3) << 2) | (dk & 3);
#else
      const int slot = dk;
#endif
      *(LAS u32x4*)(KT + slot * 72 + 8 * cg8) = pack8(k0); *(LAS u32x4*)(KT + (slot + 1) * 72 + 8 * cg8) = pack8(k1); }
    gla_stage_vt(U, T0, h, VT, tid);
    __syncthreads();
    f32x4 acc[2][8];
#pragma unroll
    for (int mt = 0; mt < 2; ++mt)
#pragma unroll
        for (int nt = 0; nt < 8; ++nt) acc[mt][nt] = (f32x4){0.f, 0.f, 0.f, 0.f};
#pragma unroll
    for (int ks = 0; ks < 2; ++ks) { bf16x8 vf[2];
#pragma unroll
        for (int mt = 0; mt < 2; ++mt) vf[mt] = *(const LAS bf16x8*)(VT + (32 * wave + 16 * mt + fr) * 72 + 32 * ks + 8 * fq);
#pragma unroll
        for (int nt = 0; nt < 8; ++nt) { const bf16x8 kf = *(const LAS bf16x8*)(KT + (16 * nt + fr) * 72 + 32 * ks + 8 * fq);
#pragma unroll
            for (int mt = 0; mt < 2; ++mt) acc[mt][nt] = MFMA16(kf, vf[mt], acc[mt][nt]); } }
    kv_t* kvp = KVT + (size_t)task * 32768;
#if B_KV16
#pragma unroll
    for (int mt = 0; mt < 2; ++mt)
#pragma unroll
        for (int p = 0; p < 4; ++p) { const f32x4 v0 = acc[mt][2 * p], v1 = acc[mt][2 * p + 1];
            u32x4 w; w.x = cvt_pk_bf16(v0[0], v0[1]); w.y = cvt_pk_bf16(v0[2], v0[3]); w.z = cvt_pk_bf16(v1[0], v1[1]); w.w = cvt_pk_bf16(v1[2], v1[3]);
            *(u32x4*)(kvp + (32 * wave + 16 * mt + fr) * 128 + 32 * p + 8 * fq) = w; }
#else
#pragma unroll
    for (int mt = 0; mt < 2; ++mt)
#pragma unroll
        for (int nt = 0; nt < 8; ++nt) *(f32x4*)(kvp + (32 * wave + 16 * mt + fr) * 128 + 16 * nt + 4 * fq) = acc[mt][nt];
#endif
    if (tid < 128) DEC[task * 128 + tid] = fexp(BC[63 * 128 + tid]);
    __syncthreads();
}
__device__ __forceinline__ void gla_scan_phase(const kv_t* KVT, st_t* ST, const float* DEC, int G, int tid) {
    for (int e = blockIdx.x * NTHR + tid; e < 16 * 8192; e += G * NTHR) {
        const int bh = e >> 13, e4 = e & 8191, dk0 = (e4 * 4) & 127;
        f32x4 st = {0.f, 0.f, 0.f, 0.f};
        for (int n0 = 0; n0 < 32; n0 += 8) { f32x4 kv[8], dc[8];
#pragma unroll
            for (int j = 0; j < 8; ++j) { const size_t idx = (size_t)(bh * 32 + n0 + j) * 32768 + e4 * 4;
#if B_KV16
                const u32x2 r = *(const u32x2*)(KVT + idx); kv[j] = (f32x4){bf_lo(r.x), bf_hi(r.x), bf_lo(r.y), bf_hi(r.y)};
#else
                kv[j] = *(const f32x4*)(KVT + idx);
#endif
                dc[j] = *(const f32x4*)(DEC + (bh * 32 + n0 + j) * 128 + dk0); }
#pragma unroll
            for (int j = 0; j < 8; ++j) { const size_t idx = (size_t)(bh * 32 + n0 + j) * 32768 + e4 * 4;
#if B_ST16
                u32x2 o; o.x = cvt_pk_bf16(st[0], st[1]); o.y = cvt_pk_bf16(st[2], st[3]); *(u32x2*)(ST + idx) = o;
#else
                *(f32x4*)(ST + idx) = st;
#endif
                st = st * dc[j] + kv[j]; } }
    }
}
__device__ __forceinline__ void gla_out_task(int task, const bf16_t* U, const float* GL, const float* w_alpha, const float* b_alpha, const bf16_t* QDg, const bf16_t* KIg, const st_t* STg, const float* gla_norm, bf16_t* Y, LAS unsigned char* lds, int tid, int wave, int lane) {
    const int b = task >> 7, h = (task >> 5) & 3, n = task & 31, T0 = b * SEQ + n * 64;
    const int fr = lane & 15, fq = lane >> 4;
    LAS bf16_t* QD = (LAS bf16_t*)(lds + 38912);
    LAS bf16_t* KI = (LAS bf16_t*)(lds + 56320);
    LAS bf16_t* SC = (LAS bf16_t*)(lds + 73728);
    LAS bf16_t* VT = (LAS bf16_t*)(lds + 82944);
    LAS float* RS = (LAS float*)(lds + 119808);
    const st_t* stp = STg + (size_t)task * 32768;
#ifndef B_LATE
#define B_LATE 0
#endif
#if B_ST16 && !B_LATE
    bf16x8 stf[4][2];
#pragma unroll
    for (int ks = 0; ks < 4; ++ks)
#pragma unroll
        for (int nt = 0; nt < 2; ++nt) stf[ks][nt] = *(const bf16x8*)(stp + (32 * wave + 16 * nt + fr) * 128 + 32 * ks + 8 * fq);
#endif
#if B_QK
#pragma unroll
    for (int i = 0; i < 2; ++i) { const int ch = tid + 512 * i, r = ch >> 4, c16 = ch & 15;
        *(LAS u32x4*)(QD + r * 136 + c16 * 8) = *(const u32x4*)(QDg + (size_t)(T0 + r) * 512 + h * 128 + c16 * 8);
        *(LAS u32x4*)(KI + r * 136 + c16 * 8) = *(const u32x4*)(KIg + (size_t)(T0 + r) * 512 + h * 128 + c16 * 8); }
#else
    { LAS float* GLs = (LAS float*)(lds + GL_OFF); LAS float* BC = (LAS float*)(lds + BC_OFF); LAS float* SEG = (LAS float*)(lds + SEG_OFF);
      gla_bcum(GL, w_alpha, b_alpha, T0, h, GLs, BC, SEG, tid);
      const int dp = tid & 63, cg8 = tid >> 6; LAS unsigned* QD32 = (LAS unsigned*)QD; LAS unsigned* KI32 = (LAS unsigned*)KI; const float qs = 0.08838834764831845f;
#pragma unroll
      for (int cc = 0; cc < 8; ++cc) { const int c = 8 * cg8 + cc; const bf16_t* up = U + (size_t)(T0 + c) * DU + h * 128 + 2 * dp;
          const unsigned q2 = *(const unsigned*)(up + OQ), k2 = *(const unsigned*)(up + OKK); const float b0 = BC[c * 128 + 2 * dp], b1 = BC[c * 128 + 2 * dp + 1];
          QD32[c * 68 + dp] = cvt_pk_bf16(bf_lo(q2) * qs * fexp(b0), bf_hi(q2) * qs * fexp(b1));
          KI32[c * 68 + dp] = cvt_pk_bf16(bf_lo(k2) * fexp(-b0), bf_hi(k2) * fexp(-b1)); } }
#endif
    gla_stage_vt(U, T0, h, VT, tid);
    __syncthreads();
    { const int it = wave & 3, jp = wave >> 2;
#pragma unroll
      for (int jj = 0; jj < 2; ++jj) { const int jt = 2 * jp + jj; f32x4 s = {0.f, 0.f, 0.f, 0.f};
          if (jt <= it) {
#pragma unroll
              for (int ks = 0; ks < 4; ++ks) { const bf16x8 kf = *(const LAS bf16x8*)(KI + (16 * jt + fr) * 136 + 32 * ks + 8 * fq); const bf16x8 qf = *(const LAS bf16x8*)(QD + (16 * it + fr) * 136 + 32 * ks + 8 * fq);
                  s = MFMA16(kf, qf, s); } }
          const int i = 16 * it + fr, j0 = 16 * jt + 4 * fq;
          u32x2 o; o.x = cvt_pk_bf16(j0 + 0 <= i ? s[0] : 0.f, j0 + 1 <= i ? s[1] : 0.f); o.y = cvt_pk_bf16(j0 + 2 <= i ? s[2] : 0.f, j0 + 3 <= i ? s[3] : 0.f);
          *(LAS u32x2*)(SC + i * 72 + j0) = o; } }
    __syncthreads();
    f32x4 acc[4][2];
#pragma unroll
    for (int mt = 0; mt < 4; ++mt)
#pragma unroll
        for (int nt = 0; nt < 2; ++nt) acc[mt][nt] = (f32x4){0.f, 0.f, 0.f, 0.f};
#pragma unroll
    for (int ks = 0; ks < 2; ++ks) { bf16x8 vf[2];
#pragma unroll
        for (int nt = 0; nt < 2; ++nt) vf[nt] = *(const LAS bf16x8*)(VT + (32 * wave + 16 * nt + fr) * 72 + 32 * ks + 8 * fq);
#pragma unroll
        for (int mt = 0; mt < 4; ++mt) { const bf16x8 sf = *(const LAS bf16x8*)(SC + (16 * mt + fr) * 72 + 32 * ks + 8 * fq);
#pragma unroll
            for (int nt = 0; nt < 2; ++nt) acc[mt][nt] = MFMA16(vf[nt], sf, acc[mt][nt]); } }
#pragma unroll
    for (int ks = 0; ks < 4; ++ks) { bf16x8 sf[2];
#pragma unroll
        for (int nt = 0; nt < 2; ++nt) {
#if B_ST16 && !B_LATE
            sf[nt] = stf[ks][nt];
#elif B_ST16
            sf[nt] = *(const bf16x8*)(stp + (32 * wave + 16 * nt + fr) * 128 + 32 * ks + 8 * fq);
#else
            const float* p = stp + (32 * wave + 16 * nt + fr) * 128 + 32 * ks + 8 * fq; const f32x4 lo = *(const f32x4*)p, hi = *(const f32x4*)(p + 4);
            u32x4 w; w.x = cvt_pk_bf16(lo[0], lo[1]); w.y = cvt_pk_bf16(lo[2], lo[3]); w.z = cvt_pk_bf16(hi[0], hi[1]); w.w = cvt_pk_bf16(hi[2], hi[3]); sf[nt] = __builtin_bit_cast(bf16x8, w);
#endif
        }
#pragma unroll
        for (int mt = 0; mt < 4; ++mt) { const bf16x8 qf = *(const LAS bf16x8*)(QD + (16 * mt + fr) * 136 + 32 * ks + 8 * fq);
#pragma unroll
            for (int nt = 0; nt < 2; ++nt) acc[mt][nt] = MFMA16(sf[nt], qf, acc[mt][nt]); } }
#pragma unroll
    for (int mt = 0; mt < 4; ++mt) { float s = 0.f;
#pragma unroll
        for (int nt = 0; nt < 2; ++nt) { const f32x4 v = acc[mt][nt]; s += (v[0] * v[0] + v[1] * v[1]) + (v[2] * v[2] + v[3] * v[3]); }
        s += __shfl_xor(s, 16); s += __shfl_xor(s, 32);
        if (fq == 0) RS[wave * 64 + 16 * mt + fr] = s; }
    __syncthreads();
#pragma unroll
    for (int mt = 0; mt < 4; ++mt) { float tot = 0.f;
#pragma unroll
        for (int w8 = 0; w8 < 8; ++w8) tot += RS[w8 * 64 + 16 * mt + fr];
        const float rstd = rsqrtf(tot * (1.0f / 256.0f) + RMS_EPS); const int tok = T0 + 16 * mt + fr;
#pragma unroll
        for (int nt = 0; nt < 2; ++nt) { const int dv = 32 * wave + 16 * nt + 4 * fq; const f32x4 gn = *(const f32x4*)(gla_norm + dv);
            const u32x2 g2 = *(const u32x2*)(U + (size_t)tok * DU + OG + h * 256 + dv); const f32x4 v = acc[mt][nt] * rstd * gn;
            u32x2 o; o.x = cvt_pk_bf16(v[0] * silu_f(bf_lo(g2.x)), v[1] * silu_f(bf_hi(g2.x))); o.y = cvt_pk_bf16(v[2] * silu_f(bf_lo(g2.y)), v[3] * silu_f(bf_hi(g2.y)));
            *(u32x2*)(Y + (size_t)tok * DM + 1024 + h * 256 + dv) = o; } }
    __syncthreads();
}

#define GAS __attribute__((address_space(1)))
#define XB_TMO      128
#define XB_XCNT(j)  (256  + 64 * (j))
#define XB_XSUB(j)  (1280 + 64 * (j))
#define XB_XGEN(j)  (2304 + 64 * (j))
#define XB_TOP      3328
#define XB_TOPGEN   3392
#define XCD_BAR_WORDS 3456
#define XB_SPIN_CAP (1u << 18)

__device__ __forceinline__ unsigned xb_ld(unsigned* p)              { return __hip_atomic_load(p, __ATOMIC_RELAXED, __HIP_MEMORY_SCOPE_AGENT); }
__device__ __forceinline__ unsigned xb_add(unsigned* p, unsigned v) { return __hip_atomic_fetch_add(p, v, __ATOMIC_RELAXED, __HIP_MEMORY_SCOPE_AGENT); }
__device__ __forceinline__ unsigned xb_xcc_id() { return (unsigned)__builtin_amdgcn_s_getreg((3 << 11) | 20) & 0xFu; }
#define XB_SPIN(cond, bar) do { unsigned _sp = 0; while (cond) { __builtin_amdgcn_s_sleep(1); \
    if ((++_sp & 255u) == 0u) { if (xb_ld(&(bar)[XB_TMO])) break; if (_sp > XB_SPIN_CAP) { atomicAdd(&(bar)[XB_TMO], 1u); break; } } } } while (0)

struct XcdBarrier {
    unsigned* bar; unsigned x;
    volatile LAS unsigned* st;
};

__device__ __forceinline__ XcdBarrier xcd_barrier_post(unsigned* bar, volatile LAS unsigned* st) {
    XcdBarrier b; b.bar = bar; b.x = xb_xcc_id(); b.st = st;
    if (threadIdx.x == 0) (void)xb_add(&bar[XB_XCNT(b.x)], 1u);
    return b;
}
__device__ __forceinline__ void xcd_barrier_complete(unsigned* bar, unsigned x, unsigned& nloc, unsigned& nx) {
    const unsigned G = gridDim.x * gridDim.y * gridDim.z;
    unsigned sum, cnt, mine, sp = 0u;
    for (;;) {
        sum = 0u; cnt = 0u; mine = 0u;
#pragma unroll
        for (unsigned j = 0; j < 16; ++j) { const unsigned c = xb_ld(&bar[XB_XCNT(j)]); sum += c; cnt += (c > 0u) ? 1u : 0u; mine = (j == x) ? c : mine; }
        if (sum == G) break;
        __builtin_amdgcn_s_sleep(1);
        if ((++sp & 255u) == 0u) { if (xb_ld(&bar[XB_TMO])) break; if (sp > XB_SPIN_CAP) { atomicAdd(&bar[XB_TMO], 1u); break; } }
    }
    nloc = mine > 0u ? mine : 1u; nx = cnt > 0u ? cnt : 1u;
}

__device__ __forceinline__ void xcd_barrier(const XcdBarrier& b) {
    asm volatile("s_waitcnt vmcnt(0)" ::: "memory");
    __syncthreads();
    if (threadIdx.x == 0) {
        unsigned* bar = b.bar;
        __builtin_amdgcn_s_waitcnt(0);
        unsigned nloc = b.st[0], nx = b.st[1];
        if (nloc == 0u) { xcd_barrier_complete(bar, b.x, nloc, nx); b.st[0] = nloc; b.st[1] = nx; }
        const unsigned old = xb_add(&bar[XB_XSUB(b.x)], 1u);
        const unsigned gen = old / nloc;
        if (old + 1u == (gen + 1u) * nloc) {
            __builtin_amdgcn_fence(__ATOMIC_RELEASE, "agent");
            asm volatile("s_waitcnt vmcnt(0)" ::: "memory");
            const unsigned og = xb_add(&bar[XB_TOP], 1u);
            const unsigned tg = og / nx;
            if (og + 1u == (tg + 1u) * nx) xb_add(&bar[XB_TOPGEN], 1u);
            else XB_SPIN(xb_ld(&bar[XB_TOPGEN]) == tg, bar);
            __builtin_amdgcn_fence(__ATOMIC_ACQUIRE, "agent");
            xb_add(&bar[XB_XGEN(b.x)], 1u);
            asm volatile("s_waitcnt vmcnt(0)" ::: "memory");
        } else {
            XB_SPIN(xb_ld(&bar[XB_XGEN(b.x)]) == gen, bar);
            __builtin_amdgcn_fence(__ATOMIC_ACQUIRE, "agent");
            asm volatile("s_waitcnt vmcnt(0)" ::: "memory");
        }
    }
    __syncthreads();
}

constexpr size_t WS_BAR = 1 * MiB + 512 * 1024;
__global__ void __launch_bounds__(NTHR, 2) mk_fwd(Args args) {
    extern __shared__ __attribute__((aligned(16))) unsigned char lds_raw[];
    LAS unsigned char* lds = (LAS unsigned char*)lds_raw;
    cg::grid_group grid = cg::this_grid();
    const int tid = threadIdx.x, lane = tid & 63, wave = __builtin_amdgcn_readfirstlane(tid >> 6);
    const int G = gridDim.x, bx = blockIdx.x;
    const int vcu = (G % 8 == 0) ? (bx % 8) * (G / 8) + bx / 8 : bx;
    const int gw = vcu * NWAVES + wave, NGW = G * NWAVES;
    unsigned char* ws = args.ws;
    float* rowss = (float*)(ws + WS_ROWSS); float* GL = (float*)(ws + WS_GL); float* DEC = (float*)(ws + WS_DEC);
    bf16_t* A = (bf16_t*)(ws + WS_A); bf16_t* ACT = (bf16_t*)(ws + WS_ACT); bf16_t* U = (bf16_t*)(ws + WS_U); bf16_t* Y = (bf16_t*)(ws + WS_Y); kv_t* KVT = (kv_t*)(ws + WS_KVT); st_t* ST = (st_t*)(ws + WS_ST); bf16_t* QDg = (bf16_t*)(ws + WS_QD); bf16_t* KIg = (bf16_t*)(ws + WS_KI);
    const int lo = args.ph_lo, hi = args.ph_hi;
    if (tid < 2) ((volatile LAS unsigned*)(lds + RING_BYTES))[tid] = 0u;
    __syncthreads();
    const XcdBarrier bar = xcd_barrier_post((unsigned*)(ws + WS_BAR), (volatile LAS unsigned*)(lds + RING_BYTES));
    if (hi > 1000) grid.sync();
#define IN(k) (lo <= (k) && (k) < hi)
#define SEAM(k) do { if (IN(k) && IN((k) + 1)) xcd_barrier(bar); } while (0)

    if (IN(0)) { p0_prologue(args, lds, gw, NGW, lane, wave); }
    SEAM(0);
    if (IN(1)) { pg8::Gemm g{A, (const bf16_t*)(ws + WS_W1IN), M, 2 * DFF, DM}; pg8::StaticOrder S; S.init(M, 2 * DFF, G, bx);
        pg8::EpiSwiGLU E{ACT, DFF, rowss, INV_DM};
        pg8::gemm_phase<pg8::EpiSwiGLU, pg8::StaticOrder, true, true>(lds, g, S, E); }
    SEAM(1);
    if (IN(2)) { pg8::Gemm g{ACT, (const bf16_t*)(ws + WS_W1OUT), M, DM, DFF}; pg8::StaticOrder S; S.init(M, DM, G, bx);
        pg8::EpiResid E{args.in[0], args.out, 0.5f, A, args.in[4], rowss + M};
        pg8::gemm_phase<pg8::EpiResid, pg8::StaticOrder, true, true>(lds, g, S, E); }
    SEAM(2);
    if (IN(3)) { gatelr_phase(A, (const bf16_t*)(ws + WS_WMIX) + (size_t)DU * DM, rowss + M, GL, lds, G, tid, wave, lane);
        pg8::Gemm g{A, (const bf16_t*)(ws + WS_WMIX), M, DU, DM}; pg8::StaticOrder S; S.init(M, DU, G, bx);
        pg8::EpiScaleBf16 E{U, DU, rowss + M, INV_DM};
        pg8::gemm_phase<pg8::EpiScaleBf16, pg8::StaticOrder, true, true>(lds, g, S, E); }
    SEAM(3);
    if (IN(4)) { for (int t = bx; t < 1024; t += G) {
            if (t < 512) gla_kv_task(t, U, GL, args.in[8], args.in[9], KVT, DEC, QDg, KIg, lds, tid, wave, lane);
            else pool_task(t - 512, U, (const bf16_t*)(ws + WS_WPOOL), args.in[7], Y, lds, tid, wave, lane); } }
    SEAM(4);
    if (IN(5)) { gla_scan_phase(KVT, ST, DEC, G, tid); }
    SEAM(5);
    if (IN(6)) { for (int t = bx; t < 512; t += G) gla_out_task(t, U, GL, args.in[8], args.in[9], QDg, KIg, ST, args.in[10], Y, lds, tid, wave, lane); }
    SEAM(6);
    if (IN(7)) { pg8::Gemm g{Y, (const bf16_t*)(ws + WS_WOUT), M, DM, DM}; pg8::StaticOrder S; S.init(M, DM, G, bx);
        pg8::EpiResid E{args.out, args.out, 1.0f, A, args.in[12], rowss + 2 * M};
        pg8::gemm_phase<pg8::EpiResid, pg8::StaticOrder, true, true>(lds, g, S, E); }
    SEAM(7);
    if (IN(8)) { pg8::Gemm g{A, (const bf16_t*)(ws + WS_W2IN), M, 2 * DFF, DM}; pg8::StaticOrder S; S.init(M, 2 * DFF, G, bx);
        pg8::EpiSwiGLU E{ACT, DFF, rowss + 2 * M, INV_DM};
        pg8::gemm_phase<pg8::EpiSwiGLU, pg8::StaticOrder, true, true>(lds, g, S, E); }
    SEAM(8);
    if (IN(9)) { pg8::Gemm g{ACT, (const bf16_t*)(ws + WS_W2OUT), M, DM, DFF}; pg8::StaticOrder S; S.init(M, DM, G, bx);
        pg8::EpiResid E{args.out, args.out, 0.5f, nullptr, nullptr, rowss + 3 * M};
        pg8::gemm_phase<pg8::EpiResid, pg8::StaticOrder, true, true>(lds, g, S, E); }
    SEAM(9);
    if (IN(10)) { const float* fn = args.in[15];
        for (int m = gw; m < M; m += NGW) { f32x4* orow = (f32x4*)(args.out + (size_t)m * DM) + lane; const f32x4* gr = (const f32x4*)fn + lane;
            const float rs = rsqrtf(rowss[3 * M + m] * INV_DM + RMS_EPS);
#pragma unroll
            for (int j = 0; j < 8; ++j) { const f32x4 v = orow[64 * j]; orow[64 * j] = v * rs * gr[64 * j]; } } }
#undef IN
#undef SEAM
}

#ifndef MK_N_LAUNCHES
#define MK_N_LAUNCHES 1
#endif
extern "C" void kernel_launch(void* const* d_in, const int* in_sizes, int n_in, void* d_out, int out_size, void* d_ws, size_t ws_size, hipStream_t stream) {
    static int grid = 0;
    if (grid == 0) {
        if (n_in != 16 || out_size != M * DM || ws_size < WS_END) { fprintf(stderr, "kernel_launch: unexpected shapes (n_in %d out %d ws %zu)\n", n_in, out_size, ws_size); grid = -1; return; }
        int dev = 0, cus = 0, per_cu = 0;
        if (hipGetDevice(&dev) != hipSuccess || hipDeviceGetAttribute(&cus, hipDeviceAttributeMultiprocessorCount, dev) != hipSuccess) { grid = -1; return; }
        if (hipFuncSetAttribute((const void*)mk_fwd, hipFuncAttributeMaxDynamicSharedMemorySize, LDS_BYTES) != hipSuccess) { fprintf(stderr, "kernel_launch: hipFuncSetAttribute failed\n"); grid = -1; return; }
        if (hipOccupancyMaxActiveBlocksPerMultiprocessor(&per_cu, (const void*)mk_fwd, NTHR, LDS_BYTES) != hipSuccess || per_cu < 1) { fprintf(stderr, "kernel_launch: occupancy query says %d\n", per_cu); per_cu = 1; }
        (void)hipGetLastError();
        grid = cus;
    }
    if (grid < 0) return;
    if (hipMemsetAsync((char*)d_ws + WS_BAR, 0, XCD_BAR_WORDS * 4, stream) != hipSuccess) { fprintf(stderr, "kernel_launch: memset failed\n"); return; }
    Args a{};
    for (int i = 0; i < 16; ++i) a.in[i] = (const float*)d_in[i];
    a.out = (float*)d_out; a.ws = (unsigned char*)d_ws;
#if MK_N_LAUNCHES == 1
    a.ph_lo = 0; a.ph_hi = 11;
    void* kargs[] = {&a};
    hipError_t e = hipLaunchCooperativeKernel((const void*)mk_fwd, dim3(grid), dim3(NTHR), kargs, LDS_BYTES, stream);
    if (e != hipSuccess) fprintf(stderr, "kernel_launch: cooperative launch failed: %s (grid %d)\n", hipGetErrorString(e), grid);
#else
    for (int p = 0; p < 11; ++p) { a.ph_lo = p; a.ph_hi = p + 1; hipLaunchKernelGGL(mk_fwd, dim3(grid), dim3(NTHR), LDS_BYTES, stream, a); }
#endif
}
```
